# Optimizing an MI355X kernel written in HIP

```python
import jax, jax.numpy as jnp
from jax import lax
import numpy as np

D_MODEL = 4096
BATCH = 1
SEQ = 8192
DEPTH = 1

D_A = D_MODEL // 2
CHUNK = 128
HD_A = 128
N_HEADS_A = D_A // HD_A
D_B = D_MODEL // 2
POOL_WINDOWS = (2, 4, 8, 16)
N_POOL_GROUPS = len(POOL_WINDOWS)
POOL_GD = D_B // N_POOL_GROUPS
N_BRANCHES = 2
D_FF = 4 * D_MODEL
N_MOD = 6
IN_COLS = 2 * D_A + D_B + N_BRANCHES * D_MODEL
EPS = 1e-6

kernel_name = "gated_gmlp_pool_hybrid_block"


def rmsnorm(x, g):
    xf = x.astype(jnp.float32)
    y = xf * lax.rsqrt(jnp.mean(xf * xf, axis=-1, keepdims=True) + EPS)
    return (y * g.astype(jnp.float32)).astype(x.dtype)


def layernorm(x, g, b):
    xf = x.astype(jnp.float32)
    mu = jnp.mean(xf, axis=-1, keepdims=True)
    var = jnp.mean(jnp.square(xf - mu), axis=-1, keepdims=True)
    y = (xf - mu) * lax.rsqrt(var + EPS)
    return (y * g.astype(jnp.float32) + b.astype(jnp.float32)).astype(x.dtype)


def modulate(h, shift, scale):
    return h * (1 + scale[:, None, :]) + shift[:, None, :]


def spatial_gating(u, v, ln_v_g, ln_v_b, w_spatial, b_spatial):
    B, S, _ = u.shape
    u = jax.nn.gelu(u)
    v = layernorm(jax.nn.gelu(v), ln_v_g, ln_v_b)
    n_chunks = S // CHUNK
    vb = v.reshape(B, n_chunks, CHUNK, N_HEADS_A, HD_A)
    mask = jnp.tril(jnp.ones((CHUNK, CHUNK), dtype=bool))
    w = jnp.where(mask[None], w_spatial, jnp.zeros_like(w_spatial))
    mixed = jnp.einsum('hts,bnshd->bnthd', w, vb)
    mixed = mixed + jnp.transpose(b_spatial)[None, None, :, :, None]
    return u * mixed.reshape(B, S, D_A)


def pool_mix(p, w_pool, b_pool, pool_scale):
    B, S, _ = p.shape
    pf = p.astype(jnp.float32).reshape(B, S, N_POOL_GROUPS, POOL_GD)
    cs = jnp.cumsum(pf, axis=1)
    win = jnp.array(POOL_WINDOWS, dtype=jnp.int32)
    t = jnp.arange(S, dtype=jnp.int32)[:, None]
    lo = t - win[None, :]
    gathered = cs[:, jnp.clip(lo, 0, None), jnp.arange(N_POOL_GROUPS)[None, :], :]
    lower = jnp.where((lo >= 0)[None, :, :, None], gathered, 0.0)
    count = jnp.minimum(t + 1, win[None, :]).astype(jnp.float32)
    mean = (cs - lower) / count[None, :, :, None]
    pooled = (mean - pf).astype(p.dtype)
    y = jnp.einsum('bsgc,gcd->bsgd', pooled, w_pool) + b_pool
    return y.reshape(B, S, D_B) * pool_scale


def token_mixer(h, w_in, ln_v_g, ln_v_b, w_spatial, b_spatial, w_pool, b_pool,
                pool_scale, b_gate, w_up_a, w_up_b, w_out):
    proj = jnp.einsum('bsd,de->bse', h, w_in)
    u, v, p, ga, gb = jnp.split(
        proj, [D_A, 2 * D_A, 2 * D_A + D_B, 2 * D_A + D_B + D_MODEL], axis=-1)
    y_a = spatial_gating(u, v, ln_v_g, ln_v_b, w_spatial, b_spatial)
    y_b = pool_mix(p, w_pool, b_pool, pool_scale)
    g_a = jax.nn.sigmoid(ga + b_gate[0])
    g_b = jax.nn.sigmoid(gb + b_gate[1])
    merged = (g_a * jnp.einsum('bsc,cd->bsd', y_a, w_up_a)
              + g_b * jnp.einsum('bsc,cd->bsd', y_b, w_up_b))
    return jnp.einsum('bsd,de->bse', merged, w_out)


def channel_mixer(h, w_ff1, w_ff2):
    a = jnp.einsum('bsd,df->bsf', h, w_ff1)
    return jnp.einsum('bsf,fd->bsd', jnp.square(jax.nn.relu(a)), w_ff2)


def setup_inputs(seed: int = 0) -> dict:
    key = jax.random.key(seed)
    ks = jax.random.split(key, 24)
    f32 = jnp.float32
    L = DEPTH

    def nrm(k, shape, scale):
        return jax.random.normal(k, shape, f32) * scale

    return {
        "x": nrm(ks[0], (BATCH, SEQ, D_MODEL), 1.0),
        "c": nrm(ks[1], (BATCH, D_MODEL), 1.0),
        "w_ada": nrm(ks[2], (L, D_MODEL, N_MOD * D_MODEL), 0.5 * D_MODEL ** -0.5),
        "b_ada": nrm(ks[3], (L, N_MOD * D_MODEL), 0.01),
        "norm1_g": 1.0 + nrm(ks[4], (L, D_MODEL), 0.05),
        "w_in": nrm(ks[5], (L, D_MODEL, IN_COLS), D_MODEL ** -0.5),
        "ln_v_g": 1.0 + nrm(ks[6], (L, D_A), 0.05),
        "ln_v_b": nrm(ks[7], (L, D_A), 0.02),
        "w_spatial": nrm(ks[8], (L, N_HEADS_A, CHUNK, CHUNK), CHUNK ** -0.5),
        "b_spatial": 1.0 + nrm(ks[9], (L, N_HEADS_A, CHUNK), 0.1),
        "w_pool": nrm(ks[10], (L, N_POOL_GROUPS, POOL_GD, POOL_GD), POOL_GD ** -0.5),
        "b_pool": nrm(ks[11], (L, N_POOL_GROUPS, POOL_GD), 0.02),
        "pool_scale": 1.0 + nrm(ks[12], (L, D_B), 0.1),
        "b_gate": nrm(ks[13], (L, N_BRANCHES, D_MODEL), 0.1),
        "w_up_a": nrm(ks[14], (L, D_A, D_MODEL), D_A ** -0.5),
        "w_up_b": nrm(ks[15], (L, D_B, D_MODEL), D_B ** -0.5),
        "w_out": nrm(ks[16], (L, D_MODEL, D_MODEL), D_MODEL ** -0.5),
        "norm2_g": 1.0 + nrm(ks[17], (L, D_MODEL), 0.05),
        "w_ff1": nrm(ks[18], (L, D_MODEL, D_FF), D_MODEL ** -0.5),
        "w_ff2": nrm(ks[19], (L, D_FF, D_MODEL), D_FF ** -0.5),
        "norm_f_g": 1.0 + nrm(ks[20], (D_MODEL,), 0.05),
    }


def reference(x, c, w_ada, b_ada, norm1_g, w_in, ln_v_g, ln_v_b, w_spatial, b_spatial,
              w_pool, b_pool, pool_scale, b_gate, w_up_a, w_up_b, w_out, norm2_g,
              w_ff1, w_ff2, norm_f_g):
    c_act = jax.nn.silu(c)
    for l in range(DEPTH):
        mod = jnp.einsum('bd,de->be', c_act, w_ada[l]) + b_ada[l]
        shift1, scale1, gate1, shift2, scale2, gate2 = jnp.split(mod, N_MOD, axis=-1)
        h = modulate(rmsnorm(x, norm1_g[l]), shift1, scale1)
        y = token_mixer(h, w_in[l], ln_v_g[l], ln_v_b[l], w_spatial[l], b_spatial[l],
                        w_pool[l], b_pool[l], pool_scale[l], b_gate[l],
                        w_up_a[l], w_up_b[l], w_out[l])
        x = x + gate1[:, None, :] * y
        h = modulate(rmsnorm(x, norm2_g[l]), shift2, scale2)
        x = x + gate2[:, None, :] * channel_mixer(h, w_ff1[l], w_ff2[l])
    return rmsnorm(x, norm_f_g)
```

```cpp
#include <hip/hip_runtime.h>
#include <cstdio>
#include <cstdint>

namespace pg8 {
#define PG8_LAS __attribute__((address_space(3)))
typedef unsigned short bf16_t;
typedef short bf16x8 __attribute__((ext_vector_type(8)));
typedef float f32x4 __attribute__((ext_vector_type(4)));
typedef float f32x2 __attribute__((ext_vector_type(2)));
typedef unsigned u32x4 __attribute__((ext_vector_type(4)));
typedef unsigned u32x2 __attribute__((ext_vector_type(2)));
constexpr int BM = 256, BK = 64, HALF = 128, HTB = HALF * BK * 2  , STAGE_BYTES = 8 * HTB, NXCD = 8, WGM = 8;

__host__ __device__ __forceinline__ int lds_byte(int r, int c) { const int st = (r >> 4) * 2 + (c >> 5), rr = r & 15, cc = c & 31, ob = rr * 64 + cc * 2; return st * 1024 + (ob ^ (((ob >> 9) & 1) << 5)); }
__host__ __device__ __forceinline__ void stage_rc(int b, int& R, int& C) { const int st = b / 1024, sb = b % 1024, swz = sb ^ (((sb >> 9) & 1) << 5); R = (st >> 1) * 16 + swz / 64; C = (st & 1) * 32 + (swz % 64) / 2; }
__host__ __device__ __forceinline__ int perm32(int rho) { const int n = rho >> 4, i = rho & 15; return 8 * (i >> 2) + 4 * n + (i & 3); }

struct Unit { int pm, pn, kh; unsigned aoff, boff; };
struct Gemm { const bf16_t* A; const bf16_t* Bt; int lda, ldb, nt; };

__device__ __forceinline__ void tile_of(int L, int nM, int nN, int& pm, int& pn) {
    const int nwg = nM * nN; int wgid = L; { const int q = nwg / NXCD, r = nwg % NXCD, xcd = wgid % NXCD, off = wgid / NXCD; wgid = (xcd < r ? xcd * (q + 1) : r * (q + 1) + (xcd - r) * q) + off; }
    const int nig = WGM * nN, gid = wgid / nig, fm = gid * WGM, gsz = (nM - fm) < WGM ? (nM - fm) : WGM;
    pm = fm + ((wgid % nig) % gsz); pn = (wgid % nig) / gsz;
}
__device__ __forceinline__ unsigned cvt_pk_bf16(float lo, float hi) { unsigned r; asm volatile("v_cvt_pk_bf16_f32 %0, %1, %2" : "=v"(r) : "v"(lo), "v"(hi)); return r; }
__device__ __forceinline__ float bf_lo(unsigned w) { return __uint_as_float(w << 16); }
__device__ __forceinline__ float bf_hi(unsigned w) { return __uint_as_float(w & 0xffff0000u); }

struct NoFill { static constexpr bool ON = false; static constexpr int NPT = 0; __device__ __forceinline__ void issue(PG8_LAS unsigned char*, int) const {} __device__ __forceinline__ void consume_load(PG8_LAS unsigned char*, int, float (&)[4]) const {} __device__ __forceinline__ void consume_store(int, const float (&)[4]) const {} };
template <class Epi, class Sched, bool ALIGN_EPI = false, bool SP2 = false, class Fill = NoFill, bool F8 = false>
__device__ __forceinline__ void gemm_phase(PG8_LAS unsigned char* lds, const Gemm g, const Sched& S, const Epi& E, const Fill& F = Fill(), PG8_LAS unsigned char* scr = nullptr, int wave_ = -1) {
    static_assert(!Fill::ON || SP2, "the filler is written for the two-super-phase loop");
    int tid_ = wave_ >= 0 ? wave_ * 64 + (int)__builtin_amdgcn_mbcnt_hi(~0u, __builtin_amdgcn_mbcnt_lo(~0u, 0u)) : (int)threadIdx.x; asm volatile("" : "+v"(tid_));
    const int tid = tid_, wid = __builtin_amdgcn_readfirstlane(tid >> 6), lane = tid & 63, wr = wid >> 2, wc = wid & 3, fr = lane & 15, fq = lane >> 4;
    const int nt = g.nt;
    unsigned voffA[2], voffB[2];
#pragma unroll
    for (int i = 0; i < 2; ++i) { int R, C; stage_rc(tid * 16 + i * 8192, R, C); if (F8) C = 8 * (2 * ((C & 31) >> 3) + (C >> 5)); const int Rb = Epi::PERM ? ((R & ~31) + perm32(R & 31)) : R;
        voffA[i] = (unsigned)(R * g.lda + C) * 2u; voffB[i] = (unsigned)(Rb * g.ldb + C) * 2u; }
    const unsigned kstep = (unsigned)(BK * 2);
    const unsigned hsA = (unsigned)HALF * g.lda * 2, hsB = (unsigned)HALF * g.ldb * 2;
    const __amdgpu_buffer_rsrc_t rA = __builtin_amdgcn_make_buffer_rsrc((void*)g.A, 0, 0x7fffffff, 0x00020000), rB = __builtin_amdgcn_make_buffer_rsrc((void*)g.Bt, 0, 0x7fffffff, 0x00020000);
    const unsigned ldsw = (unsigned)wid * 1024u;
    const int aoff = lds_byte(wr * 64 + fr, fq * 8), boff = lds_byte(wc * 32 + fr, fq * 8);
#define PG8_SA(b, h) (((b) * 2 + (h)) * HTB)
#define PG8_SB(b, h) ((4 + (b) * 2 + (h)) * HTB)
#define PG8_STAGE_(bufoff, rs, soff, voff) do { _Pragma("unroll") for (int _i = 0; _i < 2; ++_i) \
        __builtin_amdgcn_raw_ptr_buffer_load_lds(rs, (PG8_LAS void*)(lds + (bufoff) + ldsw + _i * 8192), 16, (voff)[_i], (soff), 0, 0); } while (0)
#define PG8_STAGEA(bufoff, soff) PG8_STAGE_(bufoff, rA, soff, voffA)
#define PG8_STAGEB(bufoff, soff) PG8_STAGE_(bufoff, rB, soff, voffB)
#define PG8_LDA(dst, b, h) do { _Pragma("unroll") for (int m = 0; m < 4; ++m) { if constexpr (F8) { const v4i_ lo_ = *(const PG8_LAS v4i_*)(lds + PG8_SA(b, h) + aoff + m * 2048), hi_ = *(const PG8_LAS v4i_*)(lds + PG8_SA(b, h) + aoff + m * 2048 + 1024); \
        dst##8[m] = __builtin_shufflevector(lo_, hi_, 0, 1, 2, 3, 4, 5, 6, 7); } else { _Pragma("unroll") for (int k = 0; k < 2; ++k) dst[m][k] = *(const PG8_LAS bf16x8*)(lds + PG8_SA(b, h) + aoff + m * 2048 + k * 1024); } } } while (0)
#define PG8_LDB(dst, b, h) do { _Pragma("unroll") for (int n = 0; n < 2; ++n) { if constexpr (F8) { const v4i_ lo_ = *(const PG8_LAS v4i_*)(lds + PG8_SB(b, h) + boff + n * 2048), hi_ = *(const PG8_LAS v4i_*)(lds + PG8_SB(b, h) + boff + n * 2048 + 1024); \
        dst##8[n] = __builtin_shufflevector(lo_, hi_, 0, 1, 2, 3, 4, 5, 6, 7); } else { _Pragma("unroll") for (int k = 0; k < 2; ++k) dst[n][k] = *(const PG8_LAS bf16x8*)(lds + PG8_SB(b, h) + boff + n * 2048 + k * 1024); } } } while (0)
#define PG8_MMA(ai, bj, At, Bt) do { __builtin_amdgcn_s_setprio(1); \
          \
        if constexpr (F8) { _Pragma("unroll") for (int p_ = 0; p_ < 4; ++p_) _Pragma("unroll") for (int m = 0; m < 4; ++m) _Pragma("unroll") for (int n = 0; n < 2; ++n) { \
            const long a_ = ((long)(unsigned)Bt##8[n][2 * p_ + 1] << 32) | (unsigned)Bt##8[n][2 * p_], b_ = ((long)(unsigned)At##8[m][2 * p_ + 1] << 32) | (unsigned)At##8[m][2 * p_]; \
            asm volatile("v_mfma_f32_16x16x32_fp8_fp8 %0, %1, %2, %0" : "+v"(acc[ai][bj][m][n]) : "v"(a_), "v"(b_)); } }   \
        else { _Pragma("unroll") for (int k = 0; k < 2; ++k) _Pragma("unroll") for (int m = 0; m < 4; ++m) _Pragma("unroll") for (int n = 0; n < 2; ++n) \
            asm volatile("v_mfma_f32_16x16x32_bf16 %0, %1, %2, %0" : "+v"(acc[ai][bj][m][n]) : "v"(Bt[n][k]), "v"(At[m][k])); } \
        __builtin_amdgcn_s_setprio(0); } while (0)
#define PG8_WAIT_V(n) asm volatile("s_waitcnt vmcnt(" #n ")" ::: "memory")
#define PG8_WAIT_VF(SP) do { if constexpr (Fill::NPT == 2) { if constexpr (SP == 1) asm volatile("s_waitcnt vmcnt(12)" ::: "memory"); else asm volatile("s_waitcnt vmcnt(10)" ::: "memory"); } \
        else if constexpr (Fill::NPT == 1) asm volatile("s_waitcnt vmcnt(9)" ::: "memory"); else asm volatile("s_waitcnt vmcnt(8)" ::: "memory"); } while (0)
#define PG8_WAIT_L(n) asm volatile("s_waitcnt lgkmcnt(" #n ")" ::: "memory")
#define PG8_BAR __builtin_amdgcn_s_barrier()
#define PG8_SCHED __builtin_amdgcn_sched_barrier(0)
    float fcv[4] = {0.f, 0.f, 0.f, 0.f};
    Unit cur, nxt; int ui = 0; int fi = 0;
    if (!S.next(0, cur)) return;
    f32x4 acc[2][2][4][2];
#pragma unroll
    for (int a = 0; a < 2; ++a)
#pragma unroll
        for (int b = 0; b < 2; ++b)
#pragma unroll
            for (int m = 0; m < 4; ++m)
#pragma unroll
                for (int n = 0; n < 2; ++n) acc[a][b][m][n] = (f32x4){0.f, 0.f, 0.f, 0.f};
    bf16x8 At[4][2], B0[2][2], B1[2][2];
    typedef int v4i_ __attribute__((ext_vector_type(4))); typedef int v8i_ __attribute__((ext_vector_type(8)));
    v8i_ At8[4], B08[2], B18[2];
    unsigned cA = cur.aoff, cB = cur.boff;
    if constexpr (SP2) {
        PG8_STAGEB(PG8_SB(0, 0), cB); PG8_STAGEB(PG8_SB(0, 1), cB + hsB); PG8_STAGEA(PG8_SA(0, 0), cA); PG8_STAGEA(PG8_SA(0, 1), cA + hsA);
        if (wr == 1) PG8_BAR;
        PG8_WAIT_V(2); PG8_BAR;
        PG8_STAGEB(PG8_SB(1, 0), cB + kstep); PG8_STAGEA(PG8_SA(1, 0), cA + kstep); PG8_STAGEB(PG8_SB(1, 1), cB + hsB + kstep);
        PG8_WAIT_V(6); PG8_BAR;
    } else {
        PG8_STAGEB(PG8_SB(0, 0), cB); PG8_STAGEA(PG8_SA(0, 0), cA); PG8_STAGEB(PG8_SB(0, 1), cB + hsB); PG8_STAGEA(PG8_SA(0, 1), cA + hsA);
        if (wr == 1) PG8_BAR;
        PG8_WAIT_V(4); PG8_BAR;
        PG8_STAGEB(PG8_SB(1, 0), cB + kstep); PG8_STAGEA(PG8_SA(1, 0), cA + kstep); PG8_STAGEB(PG8_SB(1, 1), cB + hsB + kstep);
        PG8_WAIT_V(6); PG8_BAR;
    }
    for (;;) {
        const bool has_next = S.next(ui + 1, nxt);
        const unsigned nA = has_next ? nxt.aoff : cA, nB = has_next ? nxt.boff : cB;
        for (int t = 0; t < nt; t += 2) {
            const bool last = (t == nt - 2);
            const unsigned a1 = cA + (unsigned)(t + 1) * kstep;
            const unsigned a2 = last ? nA : cA + (unsigned)(t + 2) * kstep, b2 = last ? nB : cB + (unsigned)(t + 2) * kstep;
            const unsigned a3 = a2 + kstep, b3 = b2 + kstep;
                        if constexpr (SP2) {
            if constexpr (Fill::NPT == 2) F.consume_load(scr, 2 * fi - 2, fcv);
            PG8_LDB(B0, 0, 0); PG8_LDB(B1, 0, 1); PG8_SCHED; PG8_LDA(At, 0, 0); PG8_STAGEA(PG8_SA(1, 1), a1 + hsA);
            if constexpr (Fill::NPT == 2) { F.issue(scr, 2 * fi); F.consume_store(2 * fi - 2, fcv); } else if constexpr (Fill::ON) F.issue(scr, fi);
            PG8_WAIT_VF(1); PG8_WAIT_L(0); PG8_BAR; PG8_MMA(0, 0, At, B0); PG8_MMA(0, 1, At, B1); PG8_BAR; PG8_SCHED;
            PG8_LDA(At, 0, 1); PG8_STAGEB(PG8_SB(0, 0), b2); PG8_STAGEB(PG8_SB(0, 1), b2 + hsB); PG8_STAGEA(PG8_SA(0, 0), a2);
            PG8_WAIT_VF(2); PG8_WAIT_L(0); PG8_BAR; PG8_MMA(1, 0, At, B0); PG8_MMA(1, 1, At, B1); PG8_BAR; PG8_SCHED;
            if constexpr (Fill::NPT == 2) F.consume_load(scr, 2 * fi - 1, fcv); else if constexpr (Fill::ON) F.consume_load(scr, fi - 1, fcv);
            PG8_LDB(B0, 1, 0); PG8_LDB(B1, 1, 1); PG8_SCHED; PG8_LDA(At, 1, 0); PG8_STAGEA(PG8_SA(0, 1), a2 + hsA);
            if constexpr (Fill::NPT == 2) { F.issue(scr, 2 * fi + 1); F.consume_store(2 * fi - 1, fcv); } else if constexpr (Fill::ON) F.consume_store(fi - 1, fcv);
            PG8_WAIT_VF(1); PG8_WAIT_L(0); PG8_BAR; PG8_MMA(0, 0, At, B0); PG8_MMA(0, 1, At, B1); PG8_BAR; PG8_SCHED;
            PG8_LDA(At, 1, 1); PG8_STAGEB(PG8_SB(1, 0), b3); PG8_STAGEB(PG8_SB(1, 1), b3 + hsB); PG8_STAGEA(PG8_SA(1, 0), a3);
            PG8_WAIT_VF(2); ++fi; PG8_WAIT_L(0); PG8_BAR; PG8_MMA(1, 0, At, B0); PG8_MMA(1, 1, At, B1); PG8_BAR; PG8_SCHED;
            } else {
            PG8_LDB(B0, 0, 0); PG8_SCHED; PG8_LDA(At, 0, 0); PG8_STAGEA(PG8_SA(1, 1), a1 + hsA);
            PG8_WAIT_L(8); PG8_BAR; PG8_WAIT_L(0); PG8_MMA(0, 0, At, B0); PG8_BAR; PG8_SCHED;
            PG8_LDB(B1, 0, 1); PG8_STAGEB(PG8_SB(0, 0), b2);
            PG8_BAR; PG8_WAIT_L(0); PG8_MMA(0, 1, At, B1); PG8_BAR;
            PG8_LDA(At, 0, 1); PG8_STAGEA(PG8_SA(0, 0), a2);
            PG8_BAR; PG8_WAIT_L(0); PG8_MMA(1, 0, At, B0); PG8_BAR; PG8_SCHED;
            PG8_STAGEB(PG8_SB(0, 1), b2 + hsB);
            PG8_WAIT_V(6); PG8_BAR; PG8_MMA(1, 1, At, B1); PG8_BAR;
            PG8_LDB(B0, 1, 0); PG8_SCHED; PG8_LDA(At, 1, 0); PG8_STAGEA(PG8_SA(0, 1), a2 + hsA);
            PG8_WAIT_L(8); PG8_BAR; PG8_WAIT_L(0); PG8_MMA(0, 0, At, B0); PG8_BAR; PG8_SCHED;
            PG8_LDB(B1, 1, 1); PG8_STAGEB(PG8_SB(1, 0), b3);
            PG8_BAR; PG8_WAIT_L(0); PG8_MMA(0, 1, At, B1); PG8_BAR;
            PG8_LDA(At, 1, 1); PG8_STAGEA(PG8_SA(1, 0), a3);
            PG8_BAR; PG8_WAIT_L(0); PG8_MMA(1, 0, At, B0); PG8_BAR; PG8_SCHED;
            PG8_STAGEB(PG8_SB(1, 1), b3 + hsB);
            PG8_WAIT_V(6); PG8_BAR; PG8_MMA(1, 1, At, B1); PG8_BAR;
            }
        }
        if constexpr (ALIGN_EPI) { if (wr == 0) PG8_BAR; }
        asm volatile("s_nop 15\n\ts_nop 15" ::: "memory");
        E(acc, cur, wr, wc, fr, fq);
        if (!has_next) break;
        if (!E.keep(cur)) {
#pragma unroll
        for (int a = 0; a < 2; ++a)
#pragma unroll
            for (int b = 0; b < 2; ++b)
#pragma unroll
                for (int m = 0; m < 4; ++m)
#pragma unroll
                    for (int n = 0; n < 2; ++n) acc[a][b][m][n] = (f32x4){0.f, 0.f, 0.f, 0.f};
        }
        cur = nxt; cA = nA; cB = nB; ++ui;
        if constexpr (ALIGN_EPI) { if (wr == 1) PG8_BAR; }
    }
    PG8_WAIT_V(0);
    if constexpr (!ALIGN_EPI) { if (wr == 0) PG8_BAR; }
    PG8_BAR;
    if constexpr (Fill::NPT == 2) { F.consume_load(scr, 2 * fi - 2, fcv); F.consume_store(2 * fi - 2, fcv); F.consume_load(scr, 2 * fi - 1, fcv); F.consume_store(2 * fi - 1, fcv); }
    else if constexpr (Fill::ON) { F.consume_load(scr, fi - 1, fcv); F.consume_store(fi - 1, fcv); }
#undef PG8_SA
#undef PG8_SB
#undef PG8_STAGE_
#undef PG8_STAGEA
#undef PG8_STAGEB
#undef PG8_LDA
#undef PG8_LDB
#undef PG8_MMA
#undef PG8_WAIT_V
#undef PG8_WAIT_L
#undef PG8_WAIT_VF
#undef PG8_BAR
#undef PG8_SCHED
}
}


namespace pg8 {
struct SchedPlain {
    int nM, nN, G, c, lda, ldb;
    __device__ __forceinline__ bool next(int i, Unit& u) const {
        const int L = i * G + c; if (L >= nM * nN) return false;
        tile_of(L, nM, nN, u.pm, u.pn); u.kh = 0; u.aoff = (unsigned)u.pm * BM * lda * 2u; u.boff = (unsigned)u.pn * BM * ldb * 2u; return true; }
};
struct SchedIn {
    int G, c;
    __device__ __forceinline__ bool next(int i, Unit& u) const {
        const int L = i * G + c; if (L >= 32 * 16) return false;
        int pn; tile_of(L, 32, 16, u.pm, pn); if (pn >= 8) pn += 8; u.pn = pn; u.kh = 0; u.aoff = (unsigned)u.pm * BM * 4096 * 2u; u.boff = (unsigned)pn * BM * 4096 * 2u; return true; }
};
struct SchedUp {
    int G, c;
    __device__ __forceinline__ bool next(int i, Unit& u) const {
        const int L = (i >> 1) * G + c; if (L >= 32 * 16) return false;
        tile_of(L, 32, 16, u.pm, u.pn); u.kh = i & 1; u.aoff = ((unsigned)u.pm * BM * 4096 + (unsigned)u.kh * 2048) * 2u; u.boff = ((unsigned)u.pn * BM * 4096 + (unsigned)u.kh * 2048) * 2u; return true; }
};
struct SchedPool {
    int G, c;
    __device__ __forceinline__ bool next(int i, Unit& u) const {
        const int L = i * G + c; if (L >= 32 * 8) return false;
        tile_of(L, 32, 8, u.pm, u.pn); u.kh = 0; u.aoff = ((unsigned)u.pm * BM * 2048 + (unsigned)(u.pn >> 1) * 512) * 2u; u.boff = (unsigned)u.pn * BM * 512 * 2u; return true; }
};

struct PickP2 {
    const float* iWa; const float* iWb; const float* iWo; const float* iWf; unsigned oUp, oOut, oF1;
    __device__ __forceinline__ void operator()(int I, const float*& iw, unsigned& ot, int& s, int& l, int& k, int& idx) const {
        l = 4096; s = 7; k = 0;
        if (I < 4096) { iw = iWa; ot = oUp; idx = I; } else if (I < 8192) { iw = iWb; ot = oUp; k = 2048; idx = I - 4096; }
        else if (I < 16384) { iw = iWo; ot = oOut; idx = I - 8192; } else { iw = iWf; ot = oF1; s = 9; idx = I - 16384; }
    }
};
struct PickFF2 {
    const float* iW; unsigned oT;
    __device__ __forceinline__ void operator()(int I, const float*& iw, unsigned& ot, int& s, int& l, int& k, int& idx) const { iw = iW; ot = oT; s = 7; l = 16384; k = 0; idx = I; }
};
template <class Pick, int NPT_ = 1> struct FillConv {
    static constexpr bool ON = true; static constexpr int NPT = NPT_;
    __device__ __forceinline__ static unsigned slot(int i) { return NPT_ == 2 ? ((unsigned)(i + 3) % 3u) * 8192u : (unsigned)(i & 1) * 8192u; }
    Pick pick; int base, G, c; unsigned char* ws; PG8_LAS unsigned char* ptab; unsigned odump;
    __device__ __forceinline__ const float* inp(int k) const { volatile PG8_LAS unsigned* t = (volatile PG8_LAS unsigned*)ptab + 2 * k;
        const unsigned lo = __builtin_amdgcn_readfirstlane(t[0]), hi = __builtin_amdgcn_readfirstlane(t[1]); return (const float*)(((unsigned long long)hi << 32) | lo); }
    __device__ __forceinline__ void issue(PG8_LAS unsigned char* scr, int i) const {
        const float* Wp; int s, l, ko_, idx; unsigned ot; pick(base + i * G + c, Wp, ot, s, l, ko_, idx);
        const int kb = idx >> s, nb = idx & ((1 << s) - 1);
        int tid = threadIdx.x; asm volatile("" : "+v"(tid));
        const int k = tid >> 3, cc = (tid & 7) ^ ((k >> 3) & 7);
        const unsigned voff = (unsigned)(k << (s + 5)) * 4u + (unsigned)cc * 16u;
        const char* src = (const char*)(Wp + ((size_t)(64 * kb) << (s + 5)) + 32 * nb) + voff;
        __builtin_amdgcn_global_load_lds((const unsigned*)src, (PG8_LAS unsigned*)(scr + slot(i) + __builtin_amdgcn_readfirstlane(tid >> 6) * 1024), 16, 0, 0);
    }
    __device__ __forceinline__ void consume_load(PG8_LAS unsigned char* scr, int i, float (&v)[4]) const {
        int tid = threadIdx.x; asm volatile("" : "+v"(tid));
        const int n = tid >> 4, kq = tid & 15;
        const PG8_LAS float* p = (const PG8_LAS float*)(scr + slot(i) + (4 * kq) * 128 + (((n >> 2) ^ (kq >> 1)) * 16) + (n & 3) * 4);
        v[0] = p[0]; v[1] = p[32]; v[2] = p[64]; v[3] = p[96];
    }
    __device__ __forceinline__ void consume_store(int i, const float (&v)[4]) const {
        int tid = threadIdx.x; asm volatile("" : "+v"(tid));
        const int n = tid >> 4, kq = tid & 15;
        u32x2 o; o.x = cvt_pk_bf16(v[0], v[1]); o.y = cvt_pk_bf16(v[2], v[3]);
        const float* Wp; int s, l, ko_, idx; unsigned ot; pick(base + (i < 0 ? 0 : i) * G + c, Wp, ot, s, l, ko_, idx);
        const int kb = idx >> s, nb = idx & ((1 << s) - 1);
        const unsigned voff = ((unsigned)n * (unsigned)l + 4u * (unsigned)kq) * 2u;
        char* dst = (char*)((bf16_t*)(ws + ((size_t)ot << 20)) + (size_t)(32 * nb) * l + ko_ + 64 * kb) + voff;
        if (i < 0) dst = (char*)(ws + odump) + tid * 8;
        *(u32x2*)dst = o;
    }
};
#define PG8_EPI_COMMON static constexpr bool PERM = true; __device__ __forceinline__ bool keep(const Unit&) const { return false; }

struct EpiIn {
    PG8_EPI_COMMON
    unsigned char* ws; unsigned oU, oP, oGT; const float* bgate;
    __device__ __forceinline__ void operator()(f32x4 (&acc)[2][2][4][2], const Unit& u, int wr, int wc, int fr, int fq) const {
        asm volatile("" : "+v"(fr), "+v"(fq));
        const int pn = u.pn; const bool isU = pn < 8, isP = (pn >= 16 && pn < 24), isG = pn >= 24;
        bf16_t* base; int ld;
        if (isU) { base = (bf16_t*)(ws + ((size_t)oU << 20)) + pn * 256; ld = 2048; } else if (isP) { base = (bf16_t*)(ws + ((size_t)oP << 20)) + (pn - 16) * 256; ld = 2048; } else { base = (bf16_t*)(ws + ((size_t)oGT << 20)) + (pn - 24) * 256; ld = 8192; }
        const int row0 = u.pm * BM + wr * 64 + fr, col0 = wc * 32 + 8 * fq;
        const float kA = isU ? 1.5957691216f : 1.0f, kB = isU ? 0.0713548163f : 0.0f;
        f32x4 bv[2][2];
#pragma unroll
        for (int bj = 0; bj < 2; ++bj)
#pragma unroll
            for (int n = 0; n < 2; ++n) bv[bj][n] = isG ? *(const f32x4*)(bgate + (pn - 24) * 256 + col0 + bj * HALF + 4 * n) : (f32x4){0.f, 0.f, 0.f, 0.f};
#pragma unroll
        for (int ai = 0; ai < 2; ++ai)
#pragma unroll
            for (int m = 0; m < 4; ++m) { bf16_t* rowp = base + (size_t)(row0 + ai * HALF + m * 16) * ld + col0;
#pragma unroll
                for (int bj = 0; bj < 2; ++bj) { float o[8];
#pragma unroll
                    for (int e = 0; e < 8; ++e) { const float v = acc[ai][bj][m][e >> 2][e & 3] + bv[bj][e >> 2][e & 3];
                        const float z = v * (kA + kB * v * v); const float s = __builtin_amdgcn_rcpf(1.0f + __builtin_amdgcn_exp2f(-1.4426950409f * z));
                        const float a = isG ? 1.0f : v; o[e] = isP ? v : a * s; }
                    u32x4 w; w.x = cvt_pk_bf16(o[0], o[1]); w.y = cvt_pk_bf16(o[2], o[3]); w.z = cvt_pk_bf16(o[4], o[5]); w.w = cvt_pk_bf16(o[6], o[7]);
                    *(u32x4*)(rowp + bj * HALF) = w; } }
    }
};
struct EpiGate {
    PG8_EPI_COMMON
    bf16_t* GT; const float* bgate; float sc;
    __device__ __forceinline__ void operator()(f32x4 (&acc)[2][2][4][2], const Unit& u, int wr, int wc, int fr, int fq) const {
        asm volatile("" : "+v"(fr), "+v"(fq));
        const int row0 = u.pm * BM + wr * 64 + fr, col0 = u.pn * BM + wc * 32 + 8 * fq;
        f32x4 bv[2][2];
#pragma unroll
        for (int bj = 0; bj < 2; ++bj)
#pragma unroll
            for (int n = 0; n < 2; ++n) bv[bj][n] = *(const f32x4*)(bgate + col0 + bj * HALF + 4 * n);
#pragma unroll
        for (int ai = 0; ai < 2; ++ai)
#pragma unroll
            for (int m = 0; m < 4; ++m) { bf16_t* rowp = GT + (size_t)(row0 + ai * HALF + m * 16) * 8192 + col0;
#pragma unroll
                for (int bj = 0; bj < 2; ++bj) { float o[8];
#pragma unroll
                    for (int e = 0; e < 8; ++e) { const float z = acc[ai][bj][m][e >> 2][e & 3] * sc + bv[bj][e >> 2][e & 3];
                        o[e] = __builtin_amdgcn_rcpf(1.0f + __builtin_amdgcn_exp2f(-1.4426950409f * z)); }
                    u32x4 w; w.x = cvt_pk_bf16(o[0], o[1]); w.y = cvt_pk_bf16(o[2], o[3]); w.z = cvt_pk_bf16(o[4], o[5]); w.w = cvt_pk_bf16(o[6], o[7]);
                    *(u32x4*)(rowp + bj * HALF) = w; } }
    }
};
struct EpiVT {
    PG8_EPI_COMMON
    bf16_t* VT; f32x2* stats;
    __device__ __forceinline__ void operator()(f32x4 (&acc)[2][2][4][2], const Unit& u, int wr, int wc, int fr, int fq) const {
        asm volatile("" : "+v"(fr), "+v"(fq));
        const int row0 = u.pm * BM + wr * 64 + fr, col0 = u.pn * BM + wc * 32 + 8 * fq;
#pragma unroll
        for (int bj = 0; bj < 2; ++bj) {
            float s1[8], s2[8];
#pragma unroll
            for (int e = 0; e < 8; ++e) { s1[e] = 0.f; s2[e] = 0.f; }
#pragma unroll
            for (int ai = 0; ai < 2; ++ai)
#pragma unroll
                for (int m = 0; m < 4; ++m) { bf16_t* rowp = VT + (size_t)(row0 + ai * HALF + m * 16) * 8192 + col0 + bj * HALF; float o[8];
#pragma unroll
                    for (int e = 0; e < 8; ++e) { const float v = acc[ai][bj][m][e >> 2][e & 3];
                        const float z = v * (1.5957691216f + 0.0713548163f * v * v); const float s = __builtin_amdgcn_rcpf(1.0f + __builtin_amdgcn_exp2f(-1.4426950409f * z));
                        o[e] = v * s; s1[e] += o[e]; s2[e] += o[e] * o[e]; }
                    u32x4 w; w.x = cvt_pk_bf16(o[0], o[1]); w.y = cvt_pk_bf16(o[2], o[3]); w.z = cvt_pk_bf16(o[4], o[5]); w.w = cvt_pk_bf16(o[6], o[7]);
                    *(u32x4*)(rowp) = w; }
#pragma unroll
            for (int e = 0; e < 8; ++e) {
#pragma unroll
                for (int o = 1; o < 16; o <<= 1) { s1[e] += __shfl_xor(s1[e], o); s2[e] += __shfl_xor(s2[e], o); } }
            if (fr == 0) {
#pragma unroll
                for (int e = 0; e < 8; ++e) stats[(size_t)(col0 + bj * HALF + e) * 16 + u.pm * 2 + wr] = (f32x2){s1[e], s2[e]}; }
            asm volatile("" ::: "memory");
        }
    }
};
struct EpiUp {
    static constexpr bool PERM = true;
    __device__ __forceinline__ bool keep(const Unit& u) const { return u.kh == 0; }
    const bf16_t* GT; bf16_t* O;
    __device__ __forceinline__ void operator()(f32x4 (&acc)[2][2][4][2], const Unit& u, int wr, int wc, int fr, int fq) const {
        asm volatile("" : "+v"(fr), "+v"(fq));
        const int row0 = u.pm * BM + wr * 64 + fr, col0 = u.pn * BM + wc * 32 + 8 * fq;
        if (u.kh == 0) {
#pragma unroll
            for (int ai = 0; ai < 2; ++ai)
#pragma unroll
                for (int m = 0; m < 4; ++m) { const bf16_t* gp = GT + (size_t)(row0 + ai * HALF + m * 16) * 8192 + col0;
#pragma unroll
                    for (int bj = 0; bj < 2; ++bj) { const u32x4 ga = *(const u32x4*)(gp + bj * HALF), gb = *(const u32x4*)(gp + 4096 + bj * HALF);
#pragma unroll
                        for (int q = 0; q < 4; ++q) { const float r0 = bf_lo(ga[q]) * __builtin_amdgcn_rcpf(bf_lo(gb[q])), r1 = bf_hi(ga[q]) * __builtin_amdgcn_rcpf(bf_hi(gb[q]));
                            acc[ai][bj][m][q >> 1][(q & 1) * 2] *= r0; acc[ai][bj][m][q >> 1][(q & 1) * 2 + 1] *= r1; } } }
        } else {
#pragma unroll
            for (int ai = 0; ai < 2; ++ai)
#pragma unroll
                for (int m = 0; m < 4; ++m) { const size_t r = (size_t)(row0 + ai * HALF + m * 16); const bf16_t* gp = GT + r * 8192 + 4096 + col0; bf16_t* op = O + r * 4096 + col0;
#pragma unroll
                    for (int bj = 0; bj < 2; ++bj) { const u32x4 gb = *(const u32x4*)(gp + bj * HALF); u32x4 w;
#pragma unroll
                        for (int q = 0; q < 4; ++q) w[q] = cvt_pk_bf16(acc[ai][bj][m][q >> 1][(q & 1) * 2] * bf_lo(gb[q]), acc[ai][bj][m][q >> 1][(q & 1) * 2 + 1] * bf_hi(gb[q]));
                        *(u32x4*)(op + bj * HALF) = w; } }
        }
    }
};
template <bool XBF, bool OBF> struct EpiRes {
    PG8_EPI_COMMON
    const void* X; const float* gate; void* O;
    static __device__ __forceinline__ f32x4 up_lo(u32x4 w) { return (f32x4){__uint_as_float(w.x << 16), __uint_as_float(w.x & 0xffff0000u), __uint_as_float(w.y << 16), __uint_as_float(w.y & 0xffff0000u)}; }
    static __device__ __forceinline__ f32x4 up_hi(u32x4 w) { return (f32x4){__uint_as_float(w.z << 16), __uint_as_float(w.z & 0xffff0000u), __uint_as_float(w.w << 16), __uint_as_float(w.w & 0xffff0000u)}; }
    __device__ __forceinline__ void operator()(f32x4 (&acc)[2][2][4][2], const Unit& u, int wr, int wc, int fr, int fq) const {
        asm volatile("" : "+v"(fr), "+v"(fq));
        const int row0 = u.pm * BM + wr * 64 + fr, col0 = u.pn * BM + wc * 32 + 8 * fq;
        f32x4 gv[2][2];
#pragma unroll
        for (int bj = 0; bj < 2; ++bj)
#pragma unroll
            for (int n = 0; n < 2; ++n) gv[bj][n] = *(const f32x4*)(gate + col0 + bj * HALF + 4 * n);
        f32x4 xv[2][2], xn[2][2]; u32x4 bv[2], bn[2];
        { const size_t off = (size_t)row0 * 4096 + col0;
#pragma unroll
          for (int bj = 0; bj < 2; ++bj) { if constexpr (XBF) bv[bj] = *(const u32x4*)((const bf16_t*)X + off + bj * HALF);
              else {
#pragma unroll
                  for (int n = 0; n < 2; ++n) xv[bj][n] = *(const f32x4*)((const float*)X + off + bj * HALF + 4 * n); } } }
#pragma unroll
        for (int g = 0; g < 8; ++g) { const int ai = g >> 2, m = g & 3;
            if (g + 1 < 8) { const size_t offn = (size_t)(row0 + ((g + 1) >> 2) * HALF + ((g + 1) & 3) * 16) * 4096 + col0;
#pragma unroll
                for (int bj = 0; bj < 2; ++bj) { if constexpr (XBF) bn[bj] = *(const u32x4*)((const bf16_t*)X + offn + bj * HALF);
                    else {
#pragma unroll
                        for (int n = 0; n < 2; ++n) xn[bj][n] = *(const f32x4*)((const float*)X + offn + bj * HALF + 4 * n); } } }
            const size_t off = (size_t)(row0 + ai * HALF + m * 16) * 4096 + col0;
#pragma unroll
            for (int bj = 0; bj < 2; ++bj) {
                f32x4 r0, r1;
                if constexpr (XBF) { r0 = up_lo(bv[bj]); r1 = up_hi(bv[bj]); } else { r0 = xv[bj][0]; r1 = xv[bj][1]; }
                r0 = r0 + gv[bj][0] * acc[ai][bj][m][0]; r1 = r1 + gv[bj][1] * acc[ai][bj][m][1];
                if constexpr (OBF) { u32x4 w; w.x = cvt_pk_bf16(r0.x, r0.y); w.y = cvt_pk_bf16(r0.z, r0.w); w.z = cvt_pk_bf16(r1.x, r1.y); w.w = cvt_pk_bf16(r1.z, r1.w);
                    *(u32x4*)((bf16_t*)O + off + bj * HALF) = w; }
                else { *(f32x4*)((float*)O + off + bj * HALF) = r0; *(f32x4*)((float*)O + off + bj * HALF + 4) = r1; } }
#pragma unroll
            for (int bj = 0; bj < 2; ++bj) { if constexpr (XBF) bv[bj] = bn[bj]; else {
#pragma unroll
                for (int n = 0; n < 2; ++n) xv[bj][n] = xn[bj][n]; } }
        }
    }
};
struct EpiFF1 {
    PG8_EPI_COMMON
    bf16_t* O;
    __device__ __forceinline__ void operator()(f32x4 (&acc)[2][2][4][2], const Unit& u, int wr, int wc, int fr, int fq) const {
        asm volatile("" : "+v"(fr), "+v"(fq));
        const int row0 = u.pm * BM + wr * 64 + fr, col0 = u.pn * BM + wc * 32 + 8 * fq;
#pragma unroll
        for (int ai = 0; ai < 2; ++ai)
#pragma unroll
            for (int m = 0; m < 4; ++m) { bf16_t* rowp = O + (size_t)(row0 + ai * HALF + m * 16) * 16384 + col0;
#pragma unroll
                for (int bj = 0; bj < 2; ++bj) { float o[8];
#pragma unroll
                    for (int e = 0; e < 8; ++e) { const float v = fmaxf(acc[ai][bj][m][e >> 2][e & 3], 0.f); o[e] = v * v; }
                    u32x4 w; w.x = cvt_pk_bf16(o[0], o[1]); w.y = cvt_pk_bf16(o[2], o[3]); w.z = cvt_pk_bf16(o[4], o[5]); w.w = cvt_pk_bf16(o[6], o[7]);
                    *(u32x4*)(rowp + bj * HALF) = w; } }
    }
};
struct EpiPool {
    PG8_EPI_COMMON
    bf16_t* O; const float* bias; const float* scale;
    __device__ __forceinline__ void operator()(f32x4 (&acc)[2][2][4][2], const Unit& u, int wr, int wc, int fr, int fq) const {
        asm volatile("" : "+v"(fr), "+v"(fq));
        const int row0 = u.pm * BM + wr * 64 + fr, col0 = u.pn * BM + wc * 32 + 8 * fq;
        f32x4 bv[2][2], sv[2][2];
#pragma unroll
        for (int bj = 0; bj < 2; ++bj)
#pragma unroll
            for (int n = 0; n < 2; ++n) { bv[bj][n] = *(const f32x4*)(bias + col0 + bj * HALF + 4 * n); sv[bj][n] = *(const f32x4*)(scale + col0 + bj * HALF + 4 * n); }
#pragma unroll
        for (int ai = 0; ai < 2; ++ai)
#pragma unroll
            for (int m = 0; m < 4; ++m) { bf16_t* rowp = O + (size_t)(row0 + ai * HALF + m * 16) * 4096 + 2048 + col0;
#pragma unroll
                for (int bj = 0; bj < 2; ++bj) { const f32x4 v0 = (acc[ai][bj][m][0] + bv[bj][0]) * sv[bj][0], v1 = (acc[ai][bj][m][1] + bv[bj][1]) * sv[bj][1];
                    u32x4 w; w.x = cvt_pk_bf16(v0[0], v0[1]); w.y = cvt_pk_bf16(v0[2], v0[3]); w.z = cvt_pk_bf16(v1[0], v1[1]); w.w = cvt_pk_bf16(v1[2], v1[3]);
                    *(u32x4*)(rowp + bj * HALF) = w; } }
    }
};
}

constexpr int NWAVES = 8;
#ifndef MK_PER_PHASE
#define MK_PER_PHASE 0
#endif
#ifndef MK_FILL
#define MK_FILL 0
#endif
#ifndef PG8_SP2
#define PG8_SP2 true
#endif
#ifndef PG8_ALIGN
#define PG8_ALIGN true
#endif
constexpr int N_PHASES = 11;
constexpr int SEQ = 8192, DM = 4096, DA = 2048, DB = 2048, DFF = 16384, INC = 14336, NMODV = 6 * 4096;
constexpr int NH = 16, HD = 128, CHK = 128, NCHUNK = SEQ / CHK;
constexpr float EPS = 1e-6f;

constexpr size_t MiB = 1u << 20;
constexpr bool X1_BF16 = true, X2_BF16 = true;
constexpr size_t WS_CTL = 0, CTL_ZERO_BYTES = 64 * 1024;
constexpr size_t WS_MOD = 1 * MiB;
constexpr size_t WS_STATS = 2 * MiB;
constexpr size_t WS_DUMP = 1 * MiB + 512 * 1024;
constexpr size_t WS_WSP = 3 * MiB;
constexpr size_t WS_WPOOL = 4 * MiB;
constexpr size_t WS_WIN = 8 * MiB;
constexpr size_t WS_WUP = WS_WIN + 112 * MiB;
constexpr size_t WS_WOUT = WS_WUP + 32 * MiB;
constexpr size_t WS_WFF1 = WS_WOUT + 32 * MiB;
constexpr size_t WS_WFF2 = WS_WFF1 + 128 * MiB;
constexpr size_t WS_H = WS_WFF2 + 128 * MiB;
constexpr size_t WS_U = WS_H + 64 * MiB;
constexpr size_t WS_VT = WS_U + 32 * MiB;
constexpr size_t WS_P = WS_VT + 32 * MiB;
constexpr size_t WS_GT = WS_P + 32 * MiB;
constexpr size_t WS_ACAT = WS_GT + 128 * MiB;
constexpr size_t WS_POOLED = WS_ACAT + 64 * MiB;
constexpr size_t WS_MERGED = WS_POOLED + 32 * MiB;
constexpr size_t WS_X1 = WS_MERGED + 64 * MiB;
constexpr size_t WS_HID = WS_X1 + 128 * MiB;
constexpr size_t WS_H8 = WS_HID + 256 * MiB;
constexpr size_t WS_W8 = WS_H8 + 32 * MiB;
constexpr size_t WS_END = WS_W8 + 32 * MiB;
constexpr float W8_SCALE = 64.0f;
constexpr int CW_BAR = 0;
constexpr int RING_OFF = 0, RING_BYTES = 131072;
constexpr int LDSCTL_OFF = RING_BYTES, MISC_OFF = LDSCTL_OFF + 320;
constexpr int PTAB_OFF = RING_BYTES + 512;
constexpr int SCR_OFF = RING_BYTES + 1024, SCR_BYTES = 24576;
constexpr int LDS_BYTES = 156672;

#define GAS __attribute__((address_space(1)))
#define LAS __attribute__((address_space(3)))
typedef unsigned short bf16;
typedef unsigned v4u __attribute__((ext_vector_type(4)));
typedef unsigned v2u __attribute__((ext_vector_type(2)));
typedef float f32x4 __attribute__((ext_vector_type(4)));
typedef float f32x2 __attribute__((ext_vector_type(2)));
typedef short bf16x8 __attribute__((ext_vector_type(8)));
typedef GAS unsigned gu32;
#define RLX_AGENT __ATOMIC_RELAXED, __HIP_MEMORY_SCOPE_AGENT
#define LDS_WAIT() asm volatile("s_waitcnt lgkmcnt(0)" ::: "memory")
#define VM_WAIT() asm volatile("s_waitcnt vmcnt(0)" ::: "memory")
__device__ __forceinline__ unsigned f2bf(float f) { unsigned u = __builtin_bit_cast(unsigned, f); return (u + 0x7fffu + ((u >> 16) & 1u)) >> 16; }
__device__ __forceinline__ unsigned pk2(float lo, float hi) { return f2bf(lo) | (f2bf(hi) << 16); }
__device__ __forceinline__ float bflo(unsigned w) { return __uint_as_float(w << 16); }
__device__ __forceinline__ float bfhi(unsigned w) { return __uint_as_float(w & 0xffff0000u); }

#define XB_TMO      128
#define XB_XCNT(j)  (256  + 64 * (j))
#define XB_XSUB(j)  (1280 + 64 * (j))
#define XB_XGEN(j)  (2304 + 64 * (j))
#define XB_TOP      3328
#define XB_TOPGEN   3392
#define XCD_BAR_WORDS 3456
#define XB_SPIN_CAP (1u << 18)

__device__ __forceinline__ unsigned xb_ld(unsigned* p)              { return __hip_atomic_load(p, __ATOMIC_RELAXED, __HIP_MEMORY_SCOPE_AGENT); }
__device__ __forceinline__ unsigned xb_add(unsigned* p, unsigned v) { return __hip_atomic_fetch_add(p, v, __ATOMIC_RELAXED, __HIP_MEMORY_SCOPE_AGENT); }
__device__ __forceinline__ unsigned xb_xcc_id() { return (unsigned)__builtin_amdgcn_s_getreg((3 << 11) | 20) & 0xFu; }
#define XB_SPIN(cond, bar) do { unsigned _sp = 0; while (cond) { __builtin_amdgcn_s_sleep(1); \
    if ((++_sp & 255u) == 0u) { if (xb_ld(&(bar)[XB_TMO])) break; if (_sp > XB_SPIN_CAP) { atomicAdd(&(bar)[XB_TMO], 1u); break; } } } } while (0)

struct XcdBarrier {
    unsigned* bar; unsigned x;
    volatile LAS unsigned* st;
};

__device__ __forceinline__ XcdBarrier xcd_barrier_post(unsigned* bar, volatile LAS unsigned* st) {
    XcdBarrier b; b.bar = bar; b.x = xb_xcc_id(); b.st = st;
    if (threadIdx.x == 0) (void)xb_add(&bar[XB_XCNT(b.x)], 1u);
    return b;
}
__device__ __forceinline__ void xcd_barrier_complete(unsigned* bar, unsigned x, unsigned& nloc, unsigned& nx) {
    const unsigned G = gridDim.x * gridDim.y * gridDim.z;
    unsigned sum, cnt, mine, sp = 0u;
    for (;;) {
        sum = 0u; cnt = 0u; mine = 0u;
#pragma unroll
        for (unsigned j = 0; j < 16; ++j) { const unsigned c = xb_ld(&bar[XB_XCNT(j)]); sum += c; cnt += (c > 0u) ? 1u : 0u; mine = (j == x) ? c : mine; }
        if (sum == G) break;
        __builtin_amdgcn_s_sleep(1);
        if ((++sp & 255u) == 0u) { if (xb_ld(&bar[XB_TMO])) break; if (sp > XB_SPIN_CAP) { atomicAdd(&bar[XB_TMO], 1u); break; } }
    }
    nloc = mine > 0u ? mine : 1u; nx = cnt > 0u ? cnt : 1u;
}

__device__ __forceinline__ void xcd_barrier(const XcdBarrier& b) {
    asm volatile("s_waitcnt vmcnt(0)" ::: "memory");
    __syncthreads();
    if (threadIdx.x == 0) {
        unsigned* bar = b.bar;
        __builtin_amdgcn_s_waitcnt(0);
        unsigned nloc = b.st[0], nx = b.st[1];
        if (nloc == 0u) { xcd_barrier_complete(bar, b.x, nloc, nx); b.st[0] = nloc; b.st[1] = nx; }
        const unsigned old = xb_add(&bar[XB_XSUB(b.x)], 1u);
        const unsigned gen = old / nloc;
        if (old + 1u == (gen + 1u) * nloc) {
            __builtin_amdgcn_fence(__ATOMIC_RELEASE, "agent");
            asm volatile("s_waitcnt vmcnt(0)" ::: "memory");
            const unsigned og = xb_add(&bar[XB_TOP], 1u);
            const unsigned tg = og / nx;
            if (og + 1u == (tg + 1u) * nx) xb_add(&bar[XB_TOPGEN], 1u);
            else XB_SPIN(xb_ld(&bar[XB_TOPGEN]) == tg, bar);
            __builtin_amdgcn_fence(__ATOMIC_ACQUIRE, "agent");
            xb_add(&bar[XB_XGEN(b.x)], 1u);
            asm volatile("s_waitcnt vmcnt(0)" ::: "memory");
        } else {
            XB_SPIN(xb_ld(&bar[XB_XGEN(b.x)]) == gen, bar);
            __builtin_amdgcn_fence(__ATOMIC_ACQUIRE, "agent");
            asm volatile("s_waitcnt vmcnt(0)" ::: "memory");
        }
    }
    __syncthreads();
}

struct Ctx {
    LAS unsigned char* lds;
    int tid, lane, wave, G;
    unsigned char* ws;
};
enum { IN_x, IN_c, IN_w_ada, IN_b_ada, IN_norm1_g, IN_w_in, IN_ln_v_g, IN_ln_v_b, IN_w_spatial, IN_b_spatial, IN_w_pool, IN_b_pool, IN_pool_scale, IN_b_gate, IN_w_up_a, IN_w_up_b, IN_w_out, IN_norm2_g, IN_w_ff1, IN_w_ff2, IN_norm_f_g, IN_out, IN_COUNT };
__device__ __forceinline__ float* ioptr(const Ctx& C, int k) {
    volatile LAS unsigned* t = (volatile LAS unsigned*)(C.lds + PTAB_OFF) + 2 * k;
    const unsigned lo = __builtin_amdgcn_readfirstlane(t[0]), hi = __builtin_amdgcn_readfirstlane(t[1]);
    return (float*)(((unsigned long long)hi << 32) | lo);
}
#define INP(name) ((const float*)ioptr(C, IN_##name))
#define OUTP ioptr(C, IN_out)
__device__ __forceinline__ float wave_sum(float v) {
#pragma unroll
    for (int o = 1; o < 64; o <<= 1) v += __shfl_xor(v, o);
    return v;
}
__device__ __forceinline__ void p0_transpose_item(const float* W, int N, bf16* WT, int ldk, int row_off, int k_off, LAS float* scr, int item, int lane) {
    const int nblk = N / 32, kb = item / nblk, nb = item % nblk, k0 = 64 * kb, n0 = 32 * nb;
    float wv[32];
#pragma unroll
    for (int i = 0; i < 32; ++i) wv[i] = __builtin_nontemporal_load(W + (size_t)(k0 + 2 * i + (lane >> 5)) * N + n0 + (lane & 31));
#pragma unroll
    for (int i = 0; i < 32; ++i) scr[(2 * i + (lane >> 5)) * 33 + (lane & 31)] = wv[i];
    LDS_WAIT(); asm volatile("" ::: "memory");
    const int c = lane & 7;
#pragma unroll
    for (int j = 0; j < 4; ++j) { const int n = (lane >> 3) + 8 * j; const LAS float* s = scr + (8 * c) * 33 + n;
        v4u o; o.x = pk2(s[0 * 33], s[1 * 33]); o.y = pk2(s[2 * 33], s[3 * 33]); o.z = pk2(s[4 * 33], s[5 * 33]); o.w = pk2(s[6 * 33], s[7 * 33]);
        *(GAS v4u*)(WT + (size_t)(row_off + n0 + n) * ldk + k_off + k0 + 8 * c) = o; }
    LDS_WAIT(); asm volatile("" ::: "memory");
}
__device__ __forceinline__ void p0_transpose_item_f8(const float* W, int N, unsigned char* WT, int ldk, int row_off, float sc, LAS float* scr, int item, int lane) {
    const int nblk = N / 32, kb = item / nblk, nb = item % nblk, k0 = 64 * kb, n0 = 32 * nb;
    float wv[32];
#pragma unroll
    for (int i = 0; i < 32; ++i) wv[i] = __builtin_nontemporal_load(W + (size_t)(k0 + 2 * i + (lane >> 5)) * N + n0 + (lane & 31));
#pragma unroll
    for (int i = 0; i < 32; ++i) scr[(2 * i + (lane >> 5)) * 33 + (lane & 31)] = wv[i];
    LDS_WAIT(); asm volatile("" ::: "memory");
    const int c = lane & 7;
#pragma unroll
    for (int j = 0; j < 4; ++j) { const int n = (lane >> 3) + 8 * j; const LAS float* s = scr + (8 * c) * 33 + n;
        int d0 = __builtin_amdgcn_cvt_pk_fp8_f32(s[0 * 33] * sc, s[1 * 33] * sc, 0, false); d0 = __builtin_amdgcn_cvt_pk_fp8_f32(s[2 * 33] * sc, s[3 * 33] * sc, d0, true);
        int d1 = __builtin_amdgcn_cvt_pk_fp8_f32(s[4 * 33] * sc, s[5 * 33] * sc, 0, false); d1 = __builtin_amdgcn_cvt_pk_fp8_f32(s[6 * 33] * sc, s[7 * 33] * sc, d1, true);
        *(GAS v2u*)(WT + (size_t)(row_off + n0 + n) * ldk + k0 + 8 * c) = (v2u){(unsigned)d0, (unsigned)d1}; }
    LDS_WAIT(); asm volatile("" ::: "memory");
}
__device__ __forceinline__ void p0_prologue(Ctx& C) {
    {
        LAS float* cact = (LAS float*)(C.lds);
        LAS float* red = (LAS float*)(C.lds + 16384);
        for (int i = C.tid; i < DM; i += NWAVES * 64) { const float v = INP(c)[i]; cact[i] = v / (1.0f + __expf(-v)); }
        __syncthreads();
        const int c4 = C.tid % 24, rg = C.tid / 24;
        float* mod = (float*)(C.ws + WS_MOD);
        for (int s = blockIdx.x; s < 256; s += C.G) {
            if (rg < 21) {
                f32x4 acc = (f32x4){0.f, 0.f, 0.f, 0.f};
                const float* wp = INP(w_ada) + (size_t)rg * NMODV + 96 * s + 4 * c4;
#pragma unroll 8
                for (int r = rg; r < DM; r += 21) { const f32x4 w = __builtin_nontemporal_load((const f32x4*)wp); acc += cact[r] * w; wp += (size_t)21 * NMODV; }
                *(LAS f32x4*)(red + rg * 96 + 4 * c4) = acc;
            }
            __syncthreads();
            if (C.tid < 96) { float t = 0.f;
#pragma unroll
                for (int k = 0; k < 21; ++k) t += red[k * 96 + C.tid];
                mod[96 * s + C.tid] = t + INP(b_ada)[96 * s + C.tid]; }
            __syncthreads();
        }
    }
    {
        LAS float* scr = (LAS float*)(C.lds + RING_OFF + C.wave * 16384);
        const int gw = blockIdx.x * NWAVES + C.wave, NGW = C.G * NWAVES;
#if MK_FILL
        constexpr int I_IN = (DM / 64) * (INC / 32), I_PL = (512 / 64) * (512 / 32);
        constexpr int NITEMS = I_IN + 4 * I_PL;
        bf16* WIN = (bf16*)(C.ws + WS_WIN); bf16* WPL = (bf16*)(C.ws + WS_WPOOL);
        for (int it = gw; it < NITEMS; it += NGW) {
            int r = it;
            if (r < I_IN) { p0_transpose_item(INP(w_in), INC, WIN, DM, 0, 0, scr, r, C.lane); continue; } r -= I_IN;
            { const int g = r / I_PL; p0_transpose_item(INP(w_pool) + (size_t)g * 512 * 512, 512, WPL, 512, g * 512, 0, scr, r % I_PL, C.lane); }
        }
#else
        constexpr int I_IN = (DM / 64) * (INC / 32), I_F1 = (DM / 64) * (DFF / 32), I_F2 = (DFF / 64) * (DM / 32), I_PL = (512 / 64) * (512 / 32);
        constexpr int NITEMS = I_IN + I_F1 / 2 + I_F2 + 4 * I_PL;
        bf16* WIN = (bf16*)(C.ws + WS_WIN); bf16* WF1 = (bf16*)(C.ws + WS_WFF1); bf16* WF2 = (bf16*)(C.ws + WS_WFF2); bf16* WPL = (bf16*)(C.ws + WS_WPOOL);
        const float* p_in = INP(w_in); const float* p_f1 = INP(w_ff1); const float* p_f2 = INP(w_ff2); const float* p_pl = INP(w_pool);
        for (int it = gw; it < NITEMS; it += NGW) {
            int r = it;
            if (r < I_IN) { if ((r % (INC / 32)) * 32 >= 3 * DA) p0_transpose_item_f8(p_in, INC, (unsigned char*)(C.ws + WS_W8), DM, -3 * DA, W8_SCALE, scr, r, C.lane);
                            else p0_transpose_item(p_in, INC, WIN, DM, 0, 0, scr, r, C.lane); continue; } r -= I_IN;
            if (r < I_F1 / 2) { p0_transpose_item(p_f1, DFF, WF1, DM, 0, 0, scr, r + I_F1 / 2, C.lane); continue; } r -= I_F1 / 2;
            if (r < I_F2) { p0_transpose_item(p_f2, DM, WF2, DFF, 0, 0, scr, r, C.lane); continue; } r -= I_F2;
            { const int g = r / I_PL; p0_transpose_item(p_pl + (size_t)g * 512 * 512, 512, WPL, 512, g * 512, 0, scr, r % I_PL, C.lane); }
        }
#endif
        bf16* WSP = (bf16*)(C.ws + WS_WSP);
        for (int i = blockIdx.x * (NWAVES * 64) + C.tid; i < NH * CHK * CHK / 8; i += C.G * NWAVES * 64) {
            const int e0 = i * 8, t = (e0 >> 7) & 127, s0 = e0 & 127;
            const f32x4 a = *(const f32x4*)(INP(w_spatial) + e0), b = *(const f32x4*)(INP(w_spatial) + e0 + 4);
            float v[8] = {a.x, a.y, a.z, a.w, b.x, b.y, b.z, b.w};
#pragma unroll
            for (int e = 0; e < 8; ++e) v[e] = (s0 + e <= t) ? v[e] : 0.f;
            v4u o; o.x = pk2(v[0], v[1]); o.y = pk2(v[2], v[3]); o.z = pk2(v[4], v[5]); o.w = pk2(v[6], v[7]);
            *(v4u*)(WSP + e0) = o;
        }
    }
}
template <bool MODUL, bool XBF = false>
__device__ __forceinline__ void p_norm(Ctx& C, const void* Xv, const float* g, const float* shift, const float* scale, bf16* H, float* O, unsigned char* H8 = nullptr) {
    LAS float* ca = (LAS float*)(C.lds); LAS float* cb = (LAS float*)(C.lds + 16384);
    for (int i = C.tid; i < DM; i += NWAVES * 64) { if (MODUL) { ca[i] = g[i] * (1.0f + scale[i]); cb[i] = shift[i]; } else ca[i] = g[i]; }
    __syncthreads();
    const int gw = blockIdx.x * NWAVES + C.wave, NGW = C.G * NWAVES;
    for (int m = gw; m < SEQ; m += NGW) {
        f32x4 v[16]; float ss = 0.f;
        if constexpr (XBF) { const bf16* xr = (const bf16*)Xv + (size_t)m * DM + 8 * C.lane; v4u w[8];
#pragma unroll
            for (int j = 0; j < 8; ++j) w[j] = *(const v4u*)(xr + 512 * j);
#pragma unroll
            for (int j = 0; j < 8; ++j) { v[2 * j] = (f32x4){__uint_as_float(w[j].x << 16), __uint_as_float(w[j].x & 0xffff0000u), __uint_as_float(w[j].y << 16), __uint_as_float(w[j].y & 0xffff0000u)};
                v[2 * j + 1] = (f32x4){__uint_as_float(w[j].z << 16), __uint_as_float(w[j].z & 0xffff0000u), __uint_as_float(w[j].w << 16), __uint_as_float(w[j].w & 0xffff0000u)}; } }
        else { const float* xr = (const float*)Xv + (size_t)m * DM + 8 * C.lane;
#pragma unroll
            for (int j = 0; j < 8; ++j) { v[2 * j] = *(const f32x4*)(xr + 512 * j); v[2 * j + 1] = *(const f32x4*)(xr + 512 * j + 4); } }
#pragma unroll
        for (int j = 0; j < 16; ++j) ss += (v[j].x * v[j].x + v[j].y * v[j].y) + (v[j].z * v[j].z + v[j].w * v[j].w);
        const float rstd = 1.0f / sqrtf(wave_sum(ss) * (1.0f / DM) + EPS);
        int lo = 8 * C.lane; asm volatile("" : "+v"(lo));
#pragma unroll
        for (int j = 0; j < 8; ++j) {
            const f32x4 a0 = *(const LAS f32x4*)(ca + lo + 512 * j), a1 = *(const LAS f32x4*)(ca + lo + 512 * j + 4);
            if (MODUL) {
                const f32x4 b0 = *(const LAS f32x4*)(cb + lo + 512 * j), b1 = *(const LAS f32x4*)(cb + lo + 512 * j + 4);
                const f32x4 y0 = v[2 * j] * rstd * a0 + b0, y1 = v[2 * j + 1] * rstd * a1 + b1;
                v4u o; o.x = pk2(y0.x, y0.y); o.y = pk2(y0.z, y0.w); o.z = pk2(y1.x, y1.y); o.w = pk2(y1.z, y1.w);
                *(v4u*)(H + (size_t)m * DM + 8 * C.lane + 512 * j) = o;
                if (H8) { int d0 = __builtin_amdgcn_cvt_pk_fp8_f32(y0.x, y0.y, 0, false); d0 = __builtin_amdgcn_cvt_pk_fp8_f32(y0.z, y0.w, d0, true);
                          int d1 = __builtin_amdgcn_cvt_pk_fp8_f32(y1.x, y1.y, 0, false); d1 = __builtin_amdgcn_cvt_pk_fp8_f32(y1.z, y1.w, d1, true);
                          *(v2u*)(H8 + (size_t)m * DM + 8 * C.lane + 512 * j) = (v2u){(unsigned)d0, (unsigned)d1}; }
            } else {
                float* orow = O + (size_t)m * DM + 8 * C.lane + 512 * j;
                *(f32x4*)(orow) = v[2 * j] * rstd * a0; *(f32x4*)(orow + 4) = v[2 * j + 1] * rstd * a1;
            }
        }
    }
    __syncthreads();
}
__device__ __forceinline__ void p3_spatial(Ctx& C) {
    constexpr int LDW = 136;
    LAS bf16* WL = (LAS bf16*)(C.lds);
    LAS bf16* VL = (LAS bf16*)(C.lds + 34816);
    LAS float* MU = (LAS float*)(C.lds + 69632); LAS float* RS = MU + 128; LAS float* LG = RS + 128; LAS float* LB = LG + 128;
    const bf16* WSPb = (const bf16*)(C.ws + WS_WSP); const bf16* VT = (const bf16*)(C.ws + WS_VT); const bf16* U = (const bf16*)(C.ws + WS_U); bf16* ACAT = (bf16*)(C.ws + WS_ACAT);
    const f32x4* stats4 = (const f32x4*)(C.ws + WS_STATS);
    const int tid = C.tid, r0 = tid >> 4, c8 = tid & 15, fr = C.lane & 15, fq = C.lane >> 4, w = C.wave;
    const int NU = NCHUNK * NH;
    int hcur = -1;
    v4u vreg[4]; f32x4 sreg[2];
    int id = (int)blockIdx.x;
    if (id < NU) { const int n = id >> 4, h = id & 15;
#pragma unroll
        for (int j = 0; j < 4; ++j) vreg[j] = *(const v4u*)(VT + (size_t)(h * HD + r0 + 32 * j) * SEQ + n * CHK + c8 * 8);
        sreg[0] = stats4[(size_t)(n * CHK + (tid >> 2)) * 8 + (tid & 3) * 2]; sreg[1] = stats4[(size_t)(n * CHK + (tid >> 2)) * 8 + (tid & 3) * 2 + 1]; }
    for (; id < NU; id += C.G) {
        const int n = id >> 4, h = id & 15;
        if (h != hcur) {
            __syncthreads();
#pragma unroll
            for (int j = 0; j < 4; ++j) { const int r = r0 + 32 * j; *(LAS v4u*)(WL + r * LDW + c8 * 8) = *(const v4u*)(WSPb + (size_t)(h * CHK + r) * CHK + c8 * 8); }
            if (tid < 128) { LG[tid] = INP(ln_v_g)[h * HD + tid]; LB[tid] = INP(ln_v_b)[h * HD + tid]; }
            hcur = h;
        }
        {
            float s1 = (sreg[0].x + sreg[0].z) + (sreg[1].x + sreg[1].z), s2 = (sreg[0].y + sreg[0].w) + (sreg[1].y + sreg[1].w);
            s1 += __shfl_xor(s1, 1); s2 += __shfl_xor(s2, 1); s1 += __shfl_xor(s1, 2); s2 += __shfl_xor(s2, 2);
            const float mean = s1 * (1.0f / DA), var = fmaxf(s2 * (1.0f / DA) - mean * mean, 0.f);
            if ((tid & 3) == 0) { MU[tid >> 2] = mean; RS[tid >> 2] = 1.0f / sqrtf(var + EPS); }
        }
        __syncthreads();
#pragma unroll
        for (int j = 0; j < 4; ++j) { const int r = r0 + 32 * j; const float gg = LG[r], bb = LB[r];
            const f32x4 m0 = *(const LAS f32x4*)(MU + c8 * 8), m1 = *(const LAS f32x4*)(MU + c8 * 8 + 4), q0 = *(const LAS f32x4*)(RS + c8 * 8), q1 = *(const LAS f32x4*)(RS + c8 * 8 + 4);
            v4u o;
            o.x = pk2((bflo(vreg[j].x) - m0.x) * q0.x * gg + bb, (bfhi(vreg[j].x) - m0.y) * q0.y * gg + bb);
            o.y = pk2((bflo(vreg[j].y) - m0.z) * q0.z * gg + bb, (bfhi(vreg[j].y) - m0.w) * q0.w * gg + bb);
            o.z = pk2((bflo(vreg[j].z) - m1.x) * q1.x * gg + bb, (bfhi(vreg[j].z) - m1.y) * q1.y * gg + bb);
            o.w = pk2((bflo(vreg[j].w) - m1.z) * q1.z * gg + bb, (bfhi(vreg[j].w) - m1.w) * q1.w * gg + bb);
            *(LAS v4u*)(VL + r * LDW + c8 * 8) = o; }
        {
            const int idn = id + C.G;
            if (idn < NU) { const int nn = idn >> 4, hn = idn & 15;
#pragma unroll
                for (int j = 0; j < 4; ++j) vreg[j] = *(const v4u*)(VT + (size_t)(hn * HD + r0 + 32 * j) * SEQ + nn * CHK + c8 * 8);
                sreg[0] = stats4[(size_t)(nn * CHK + (tid >> 2)) * 8 + (tid & 3) * 2]; sreg[1] = stats4[(size_t)(nn * CHK + (tid >> 2)) * 8 + (tid & 3) * 2 + 1]; }
        }
        const int t = 16 * w + fr; const size_t tok = (size_t)n * CHK + t; const float bs = INP(b_spatial)[h * CHK + t];
        v2u uu[8];
#pragma unroll
        for (int it = 0; it < 8; ++it) uu[it] = *(const v2u*)(U + tok * DA + h * HD + 16 * it + 4 * fq);
        __syncthreads();
        f32x4 acc[8];
#pragma unroll
        for (int it = 0; it < 8; ++it) acc[it] = (f32x4){0.f, 0.f, 0.f, 0.f};
#pragma unroll
        for (int kk = 0; kk < 4; ++kk) {
            if (kk * 32 <= 16 * w + 15) {
                const bf16x8 bw = *(const LAS bf16x8*)(WL + (16 * w + fr) * LDW + kk * 32 + fq * 8);
#pragma unroll
                for (int it = 0; it < 8; ++it) { const bf16x8 av = *(const LAS bf16x8*)(VL + (16 * it + fr) * LDW + kk * 32 + fq * 8);
                    acc[it] = __builtin_amdgcn_mfma_f32_16x16x32_bf16(av, bw, acc[it], 0, 0, 0); }
            }
        }
#pragma unroll
        for (int it = 0; it < 8; ++it) { const int d0 = h * HD + 16 * it + 4 * fq;
            v2u o; o.x = pk2(bflo(uu[it].x) * (acc[it][0] + bs), bfhi(uu[it].x) * (acc[it][1] + bs)); o.y = pk2(bflo(uu[it].y) * (acc[it][2] + bs), bfhi(uu[it].y) * (acc[it][3] + bs));
            *(v2u*)(ACAT + tok * DM + d0) = o; }
    }
    __syncthreads();
}
template <int W>
__device__ __forceinline__ void p3_pool_item(const bf16* P, bf16* PO, int t0, int col) {
    v4u rows[W + 3];
#pragma unroll
    for (int j = 0; j < W + 3; ++j) { const int r = t0 - (W - 1) + j; rows[j] = *(const v4u*)(P + (size_t)(r < 0 ? 0 : r) * DB + col); }
#pragma unroll
    for (int i = 0; i < 4; ++i) { const int t = t0 + i; float sum[8];
#pragma unroll
        for (int e = 0; e < 8; ++e) sum[e] = 0.f;
#pragma unroll
        for (int j = 0; j < W; ++j) { const bool ok = (t - (W - 1) + j) >= 0; const v4u pv = rows[i + j];
#pragma unroll
            for (int q = 0; q < 4; ++q) { sum[2 * q] += ok ? bflo(pv[q]) : 0.f; sum[2 * q + 1] += ok ? bfhi(pv[q]) : 0.f; } }
        const int cnt = (t + 1 < W) ? (t + 1) : W; const float inv = 1.0f / (float)cnt; const v4u cv = rows[i + W - 1]; v4u o;
#pragma unroll
        for (int q = 0; q < 4; ++q) o[q] = pk2(sum[2 * q] * inv - bflo(cv[q]), sum[2 * q + 1] * inv - bfhi(cv[q]));
        *(v4u*)(PO + (size_t)t * DB + col) = o; }
}
__device__ __forceinline__ void p3_pooled(Ctx& C) {
    const bf16* P = (const bf16*)(C.ws + WS_P); bf16* PO = (bf16*)(C.ws + WS_POOLED);
    const int gw = blockIdx.x * NWAVES + C.wave, NGW = C.G * NWAVES;
    for (int wi = gw; wi < (SEQ / 4) * 4; wi += NGW) {
        const int g = wi & 3, t0 = (wi >> 2) * 4, col = g * 512 + C.lane * 8;
        if (g == 0) p3_pool_item<2>(P, PO, t0, col); else if (g == 1) p3_pool_item<4>(P, PO, t0, col); else if (g == 2) p3_pool_item<8>(P, PO, t0, col); else p3_pool_item<16>(P, PO, t0, col);
    }
}

#define WSP(T, off) ((T*)(C.ws + (off)))
#define MODV ((const float*)(C.ws + WS_MOD))
__device__ __forceinline__ void ph0(Ctx& C) { p0_prologue(C); }
__device__ __forceinline__ void ph1(Ctx& C) { p_norm<true>(C, INP(x), INP(norm1_g), MODV, MODV + DM, WSP(bf16, WS_H), nullptr, WSP(unsigned char, WS_H8)); }
__device__ __forceinline__ void ph2(Ctx& C) {
    const int bx = (int)blockIdx.x;
#if !defined(P2_ONLY) || P2_ONLY == 1
    { pg8::Gemm g{WSP(const bf16, WS_H), WSP(const bf16, WS_WIN), DM, DM, DM / 64}; pg8::SchedIn S{C.G, bx};
      pg8::EpiIn E{C.ws, (unsigned)(WS_U >> 20), (unsigned)(WS_P >> 20), (unsigned)(WS_GT >> 20), INP(b_gate)};
      pg8::gemm_phase<pg8::EpiIn, pg8::SchedIn, PG8_ALIGN, PG8_SP2>(C.lds + RING_OFF, g, S, E, pg8::NoFill(), nullptr, C.wave); }
#endif
#if !defined(P2_ONLY) || P2_ONLY == 3
    { pg8::Gemm g{WSP(const bf16, WS_H8), WSP(const bf16, WS_W8), DM / 2, DM / 2, DM / 128}; pg8::SchedPlain S{32, 32, C.G, bx, DM / 2, DM / 2};
      pg8::EpiGate E{WSP(bf16, WS_GT), INP(b_gate), 1.0f / W8_SCALE};
      pg8::FillConv<pg8::PickP2, 2> F{{INP(w_up_a), INP(w_up_b), INP(w_out), INP(w_ff1), (unsigned)(WS_WUP >> 20), (unsigned)(WS_WOUT >> 20), (unsigned)(WS_WFF1 >> 20)}, 0, C.G, bx, C.ws, C.lds + PTAB_OFF, (unsigned)WS_DUMP};
      pg8::gemm_phase<pg8::EpiGate, pg8::SchedPlain, PG8_ALIGN, PG8_SP2, pg8::FillConv<pg8::PickP2, 2>, true>(C.lds + RING_OFF, g, S, E, F, C.lds + SCR_OFF, C.wave); }
#endif
#if !defined(P2_ONLY) || P2_ONLY == 2
    { pg8::Gemm g{WSP(const bf16, WS_WIN) + (size_t)DA * DM, WSP(const bf16, WS_H), DM, DM, DM / 64}; pg8::SchedPlain S{8, 32, C.G, bx, DM, DM};
      pg8::EpiVT E{WSP(bf16, WS_VT), WSP(f32x2, WS_STATS)};
      pg8::gemm_phase<pg8::EpiVT, pg8::SchedPlain, PG8_ALIGN, PG8_SP2>(C.lds + RING_OFF, g, S, E, pg8::NoFill(), nullptr, C.wave); }
#endif
}
__device__ __forceinline__ void ph3(Ctx& C) {
    { const bf16* P = (const bf16*)(C.ws + WS_P); bf16* PO = (bf16*)(C.ws + WS_POOLED);
      pg8::SchedPool S{C.G, (int)blockIdx.x}; pg8::Unit u;
      for (int i = 0; S.next(i, u); ++i) { const int g = u.pn >> 1;
          for (int q = C.wave; q < 64; q += NWAVES) { const int t0 = u.pm * 256 + q * 4, col = g * 512 + C.lane * 8;
              if (g == 0) p3_pool_item<2>(P, PO, t0, col); else if (g == 1) p3_pool_item<4>(P, PO, t0, col); else if (g == 2) p3_pool_item<8>(P, PO, t0, col); else p3_pool_item<16>(P, PO, t0, col); } } }
    p3_spatial(C);
    asm volatile("s_waitcnt vmcnt(0)" ::: "memory"); __syncthreads();
    pg8::Gemm g{WSP(const bf16, WS_POOLED), WSP(const bf16, WS_WPOOL), DB, 512, 512 / 64}; pg8::SchedPool S{C.G, (int)blockIdx.x};
    pg8::EpiPool E{WSP(bf16, WS_ACAT), INP(b_pool), INP(pool_scale)};
    pg8::gemm_phase<pg8::EpiPool, pg8::SchedPool, PG8_ALIGN, PG8_SP2>(C.lds + RING_OFF, g, S, E, pg8::NoFill(), nullptr, C.wave);
}
__device__ __forceinline__ void ph4(Ctx&) {}
__device__ __forceinline__ void ph5(Ctx& C) {
    pg8::Gemm g{WSP(const bf16, WS_ACAT), WSP(const bf16, WS_WUP), DM, DM, DA / 64}; pg8::SchedUp S{C.G, (int)blockIdx.x};
    pg8::EpiUp E{WSP(const bf16, WS_GT), WSP(bf16, WS_MERGED)};
    pg8::FillConv<pg8::PickFF2> F{{INP(w_ff2), (unsigned)(WS_WFF2 >> 20)}, 0, C.G, (int)blockIdx.x, C.ws, C.lds + PTAB_OFF, (unsigned)WS_DUMP};
#if MK_FILL
    pg8::gemm_phase<pg8::EpiUp, pg8::SchedUp, PG8_ALIGN, PG8_SP2, pg8::FillConv<pg8::PickFF2>>(C.lds + RING_OFF, g, S, E, F, C.lds + SCR_OFF, C.wave);
#else
    (void)F; pg8::gemm_phase<pg8::EpiUp, pg8::SchedUp, PG8_ALIGN, PG8_SP2>(C.lds + RING_OFF, g, S, E, pg8::NoFill(), nullptr, C.wave);
#endif
}
__device__ __forceinline__ void ph6(Ctx& C) {
    pg8::Gemm g{WSP(const bf16, WS_MERGED), WSP(const bf16, WS_WOUT), DM, DM, DM / 64}; pg8::SchedPlain S{32, 16, C.G, (int)blockIdx.x, DM, DM};
    pg8::EpiRes<false, X1_BF16> E{INP(x), MODV + 2 * DM, WSP(void, WS_X1)};
    pg8::FillConv<pg8::PickFF2> F{{INP(w_ff2), (unsigned)(WS_WFF2 >> 20)}, 16384, C.G, (int)blockIdx.x, C.ws, C.lds + PTAB_OFF, (unsigned)WS_DUMP};
#if MK_FILL
    pg8::gemm_phase<pg8::EpiRes<false, X1_BF16>, pg8::SchedPlain, PG8_ALIGN, PG8_SP2, pg8::FillConv<pg8::PickFF2>>(C.lds + RING_OFF, g, S, E, F, C.lds + SCR_OFF, C.wave);
#else
    (void)F; pg8::gemm_phase<pg8::EpiRes<false, X1_BF16>, pg8::SchedPlain, PG8_ALIGN, PG8_SP2>(C.lds + RING_OFF, g, S, E, pg8::NoFill(), nullptr, C.wave);
#endif
}
__device__ __forceinline__ void ph7(Ctx& C) { p_norm<true, X1_BF16>(C, WSP(const void, WS_X1), INP(norm2_g), MODV + 3 * DM, MODV + 4 * DM, WSP(bf16, WS_H), nullptr); }
__device__ __forceinline__ void ph8(Ctx& C) {
    pg8::Gemm g{WSP(const bf16, WS_H), WSP(const bf16, WS_WFF1), DM, DM, DM / 64}; pg8::SchedPlain S{32, 64, C.G, (int)blockIdx.x, DM, DM};
    pg8::EpiFF1 E{WSP(bf16, WS_HID)};
    pg8::gemm_phase<pg8::EpiFF1, pg8::SchedPlain, PG8_ALIGN, PG8_SP2>(C.lds + RING_OFF, g, S, E, pg8::NoFill(), nullptr, C.wave);
}
__device__ __forceinline__ void ph9(Ctx& C) {
    pg8::Gemm g{WSP(const bf16, WS_HID), WSP(const bf16, WS_WFF2), DFF, DFF, DFF / 64}; pg8::SchedPlain S{32, 16, C.G, (int)blockIdx.x, DFF, DFF};
    pg8::EpiRes<X1_BF16, X2_BF16> E{WSP(const void, WS_X1), MODV + 5 * DM, X2_BF16 ? WSP(void, WS_H) : (void*)OUTP};
    pg8::gemm_phase<pg8::EpiRes<X1_BF16, X2_BF16>, pg8::SchedPlain, PG8_ALIGN, PG8_SP2>(C.lds + RING_OFF, g, S, E, pg8::NoFill(), nullptr, C.wave);
}
__device__ __forceinline__ void ph10(Ctx& C) { p_norm<false, X2_BF16>(C, X2_BF16 ? WSP(const void, WS_H) : (const void*)OUTP, INP(norm_f_g), nullptr, nullptr, nullptr, OUTP); }

#ifndef PH_MASK
#define PH_MASK 0x7ff
#endif
#ifndef REPEAT_MASK
#define REPEAT_MASK 0
#endif
struct Args { const float* in[21]; float* out; unsigned char* ws; int ph_lo, ph_hi; };
__global__ void __launch_bounds__(NWAVES * 64, 2) mk_fwd(Args args) {
    extern __shared__ __attribute__((aligned(16))) unsigned char lds[];
    Ctx C;
    C.lds = (LAS unsigned char*)lds;
    C.tid = threadIdx.x; C.lane = C.tid & 63; C.wave = __builtin_amdgcn_readfirstlane(C.tid >> 6); C.G = gridDim.x;
    C.ws = args.ws;
    unsigned char* ws = args.ws;
    volatile LAS unsigned* MISC = (volatile LAS unsigned*)(C.lds + MISC_OFF);
    for (int u = C.tid; u < (LDS_BYTES - LDSCTL_OFF) / 4; u += NWAVES * 64) ((LAS unsigned*)(C.lds + LDSCTL_OFF))[u] = 0u;
    if (C.tid < IN_COUNT) { unsigned long long p = (unsigned long long)args.out;
#pragma unroll
        for (int k = 0; k < 21; ++k) if (C.tid == k) p = (unsigned long long)args.in[k];
        LAS unsigned* tb = (LAS unsigned*)(C.lds + PTAB_OFF) + 2 * C.tid; tb[0] = (unsigned)p; tb[1] = (unsigned)(p >> 32); }
    __syncthreads();
    XcdBarrier bar; bar.bar = (unsigned*)(ws + WS_CTL) + CW_BAR; bar.x = 0; bar.st = nullptr;
    if (!MK_PER_PHASE) bar = xcd_barrier_post((unsigned*)(ws + WS_CTL) + CW_BAR, MISC + 8);
    const int lo = args.ph_lo, hi = args.ph_hi;
#define IN(k) (((PH_MASK >> (k)) & 1) && lo <= (k) && (k) < hi)
#define SEAM(k) do { if (IN(k) && IN((k) + 1)) xcd_barrier(bar); } while (0)
#define PHASE(k, fn) do { if (IN(k)) { C.lane = (int)__builtin_amdgcn_mbcnt_hi(~0u, __builtin_amdgcn_mbcnt_lo(~0u, 0u)); C.tid = C.wave * 64 + C.lane; asm volatile("" : "+v"(C.tid)); C.lane = C.tid & 63; fn(C); if ((REPEAT_MASK >> (k)) & 1) { __syncthreads(); fn(C); } } } while (0)
    PHASE(0, ph0); SEAM(0);
    PHASE(1, ph1); SEAM(1);
    PHASE(2, ph2); SEAM(2);
    PHASE(3, ph3);
    PHASE(4, ph4); SEAM(4);
    PHASE(5, ph5); SEAM(5);
    PHASE(6, ph6); SEAM(6);
    PHASE(7, ph7); SEAM(7);
    PHASE(8, ph8); SEAM(8);
    PHASE(9, ph9); SEAM(9);
    PHASE(10, ph10);
#undef IN
#undef SEAM
#undef PHASE
}

extern "C" void kernel_launch(void* const* d_in, const int* in_sizes, int n_in, void* d_out, int out_size, void* d_ws, size_t ws_size, hipStream_t stream) {
    static int grid = 0;
    if (grid == 0) {
        if (n_in != 21 || in_sizes[0] != SEQ * DM || out_size != SEQ * DM || ws_size < WS_END) { fprintf(stderr, "kernel_launch: unexpected shapes (n_in %d, in0 %d, out %d, ws %zu < %zu); nothing launched\n", n_in, n_in > 0 ? in_sizes[0] : -1, out_size, ws_size, (size_t)WS_END); grid = -1; return; }
        int dev = 0, cus = 0, per_cu = 0;
        if (hipGetDevice(&dev) != hipSuccess || hipDeviceGetAttribute(&cus, hipDeviceAttributeMultiprocessorCount, dev) != hipSuccess) { fprintf(stderr, "kernel_launch: device query failed\n"); grid = -1; return; }
        if (hipFuncSetAttribute((const void*)mk_fwd, hipFuncAttributeMaxDynamicSharedMemorySize, LDS_BYTES) != hipSuccess) { fprintf(stderr, "kernel_launch: hipFuncSetAttribute failed\n"); grid = -1; return; }
        if (hipOccupancyMaxActiveBlocksPerMultiprocessor(&per_cu, (const void*)mk_fwd, NWAVES * 64, LDS_BYTES) != hipSuccess || per_cu < 1) { fprintf(stderr, "kernel_launch: occupancy query says %d workgroups per CU\n", per_cu); }
        (void)hipGetLastError();
        if (cus != 256) fprintf(stderr, "kernel_launch: built for 256 CUs (whole rounds per phase, in-loop weight conversion deal); this device has %d\n", cus);
        grid = 256;
    }
    if (grid < 0) return;
    if (hipMemsetAsync((char*)d_ws + WS_CTL, 0, CTL_ZERO_BYTES, stream) != hipSuccess) { fprintf(stderr, "kernel_launch: memset failed\n"); return; }
    Args a{};
    for (int i = 0; i < 21; ++i) a.in[i] = (const float*)d_in[i];
    a.out = (float*)d_out; a.ws = (unsigned char*)d_ws;
#if MK_PER_PHASE
    for (int p = 0; p < N_PHASES; ++p) { a.ph_lo = p; a.ph_hi = p + 1; hipLaunchKernelGGL(mk_fwd, dim3(grid), dim3(NWAVES * 64), LDS_BYTES, stream, a); }
#else
    a.ph_lo = 0; a.ph_hi = N_PHASES; hipLaunchKernelGGL(mk_fwd, dim3(grid), dim3(NWAVES * 64), LDS_BYTES, stream, a);
#endif
    const hipError_t le = hipPeekAtLastError();
    if (le != hipSuccess) fprintf(stderr, "kernel_launch: launch failed: %s\n", hipGetErrorName(le));
}
```

```cpp
#include <hip/hip_runtime.h>
#include <cstdio>
#include <cstdint>

namespace pg8 {
#define PG8_LAS __attribute__((address_space(3)))
typedef unsigned short bf16_t;
typedef short bf16x8 __attribute__((ext_vector_type(8)));
typedef float f32x4 __attribute__((ext_vector_type(4)));
typedef float f32x2 __attribute__((ext_vector_type(2)));
typedef unsigned u32x4 __attribute__((ext_vector_type(4)));
typedef unsigned u32x2 __attribute__((ext_vector_type(2)));
constexpr int BM = 256, BK = 64, HALF = 128, HTB = HALF * BK * 2  , STAGE_BYTES = 8 * HTB, NXCD = 8, WGM = 8;

__host__ __device__ __forceinline__ int lds_byte(int r, int c) { const int st = (r >> 4) * 2 + (c >> 5), rr = r & 15, cc = c & 31, ob = rr * 64 + cc * 2; return st * 1024 + (ob ^ (((ob >> 9) & 1) << 5)); }
__host__ __device__ __forceinline__ void stage_rc(int b, int& R, int& C) { const int st = b / 1024, sb = b % 1024, swz = sb ^ (((sb >> 9) & 1) << 5); R = (st >> 1) * 16 + swz / 64; C = (st & 1) * 32 + (swz % 64) / 2; }
__host__ __device__ __forceinline__ int perm32(int rho) { const int n = rho >> 4, i = rho & 15; return 8 * (i >> 2) + 4 * n + (i & 3); }

struct Unit { int pm, pn, kh; unsigned aoff, boff; };
struct Gemm { const bf16_t* A; const bf16_t* Bt; int lda, ldb, nt; };

__device__ __forceinline__ void tile_of(int L, int nM, int nN, int& pm, int& pn) {
    const int nwg = nM * nN; int wgid = L; { const int q = nwg / NXCD, r = nwg % NXCD, xcd = wgid % NXCD, off = wgid / NXCD; wgid = (xcd < r ? xcd * (q + 1) : r * (q + 1) + (xcd - r) * q) + off; }
    const int nig = WGM * nN, gid = wgid / nig, fm = gid * WGM, gsz = (nM - fm) < WGM ? (nM - fm) : WGM;
    pm = fm + ((wgid % nig) % gsz); pn = (wgid % nig) / gsz;
}
__device__ __forceinline__ unsigned cvt_pk_bf16(float lo, float hi) { unsigned r; asm volatile("v_cvt_pk_bf16_f32 %0, %1, %2" : "=v"(r) : "v"(lo), "v"(hi)); return r; }
__device__ __forceinline__ float bf_lo(unsigned w) { return __uint_as_float(w << 16); }
__device__ __forceinline__ float bf_hi(unsigned w) { return __uint_as_float(w & 0xffff0000u); }

struct NoFill { static constexpr bool ON = false; static constexpr int NPT = 0; __device__ __forceinline__ void issue(PG8_LAS unsigned char*, int) const {} __device__ __forceinline__ void consume_load(PG8_LAS unsigned char*, int, float (&)[4]) const {} __device__ __forceinline__ void consume_store(int, const float (&)[4]) const {} };
template <class Epi, class Sched, bool ALIGN_EPI = false, bool SP2 = false, class Fill = NoFill, bool F8 = false>
__device__ __forceinline__ void gemm_phase(PG8_LAS unsigned char* lds, const Gemm g, const Sched& S, const Epi& E, const Fill& F = Fill(), PG8_LAS unsigned char* scr = nullptr, int wave_ = -1) {
    static_assert(!Fill::ON || SP2, "the filler is written for the two-super-phase loop");
    int tid_ = wave_ >= 0 ? wave_ * 64 + (int)__builtin_amdgcn_mbcnt_hi(~0u, __builtin_amdgcn_mbcnt_lo(~0u, 0u)) : (int)threadIdx.x; asm volatile("" : "+v"(tid_));
    const int tid = tid_, wid = __builtin_amdgcn_readfirstlane(tid >> 6), lane = tid & 63, wr = wid >> 2, wc = wid & 3, fr = lane & 15, fq = lane >> 4;
    const int nt = g.nt;
    unsigned voffA[2], voffB[2];
#pragma unroll
    for (int i = 0; i < 2; ++i) { int R, C; stage_rc(tid * 16 + i * 8192, R, C); if (F8) C = 8 * (2 * ((C & 31) >> 3) + (C >> 5)); const int Rb = Epi::PERM ? ((R & ~31) + perm32(R & 31)) : R;
        voffA[i] = (unsigned)(R * g.lda + C) * 2u; voffB[i] = (unsigned)(Rb * g.ldb + C) * 2u; }
    const unsigned kstep = (unsigned)(BK * 2);
    const unsigned hsA = (unsigned)HALF * g.lda * 2, hsB = (unsigned)HALF * g.ldb * 2;
    const __amdgpu_buffer_rsrc_t rA = __builtin_amdgcn_make_buffer_rsrc((void*)g.A, 0, 0x7fffffff, 0x00020000), rB = __builtin_amdgcn_make_buffer_rsrc((void*)g.Bt, 0, 0x7fffffff, 0x00020000);
    const unsigned ldsw = (unsigned)wid * 1024u;
    const int aoff = lds_byte(wr * 64 + fr, fq * 8), boff = lds_byte(wc * 32 + fr, fq * 8);
#define PG8_SA(b, h) (((b) * 2 + (h)) * HTB)
#define PG8_SB(b, h) ((4 + (b) * 2 + (h)) * HTB)
#define PG8_STAGE_(bufoff, rs, soff, voff) do { _Pragma("unroll") for (int _i = 0; _i < 2; ++_i) \
        __builtin_amdgcn_raw_ptr_buffer_load_lds(rs, (PG8_LAS void*)(lds + (bufoff) + ldsw + _i * 8192), 16, (voff)[_i], (soff), 0, 0); } while (0)
#define PG8_STAGEA(bufoff, soff) PG8_STAGE_(bufoff, rA, soff, voffA)
#define PG8_STAGEB(bufoff, soff) PG8_STAGE_(bufoff, rB, soff, voffB)
#define PG8_LDA(dst, b, h) do { _Pragma("unroll") for (int m = 0; m < 4; ++m) { if constexpr (F8) { const v4i_ lo_ = *(const PG8_LAS v4i_*)(lds + PG8_SA(b, h) + aoff + m * 2048), hi_ = *(const PG8_LAS v4i_*)(lds + PG8_SA(b, h) + aoff + m * 2048 + 1024); \
        dst##8[m] = __builtin_shufflevector(lo_, hi_, 0, 1, 2, 3, 4, 5, 6, 7); } else { _Pragma("unroll") for (int k = 0; k < 2; ++k) dst[m][k] = *(const PG8_LAS bf16x8*)(lds + PG8_SA(b, h) + aoff + m * 2048 + k * 1024); } } } while (0)
#define PG8_LDB(dst, b, h) do { _Pragma("unroll") for (int n = 0; n < 2; ++n) { if constexpr (F8) { const v4i_ lo_ = *(const PG8_LAS v4i_*)(lds + PG8_SB(b, h) + boff + n * 2048), hi_ = *(const PG8_LAS v4i_*)(lds + PG8_SB(b, h) + boff + n * 2048 + 1024); \
        dst##8[n] = __builtin_shufflevector(lo_, hi_, 0, 1, 2, 3, 4, 5, 6, 7); } else { _Pragma("unroll") for (int k = 0; k < 2; ++k) dst[n][k] = *(const PG8_LAS bf16x8*)(lds + PG8_SB(b, h) + boff + n * 2048 + k * 1024); } } } while (0)
#define PG8_MMA(ai, bj, At, Bt) do { __builtin_amdgcn_s_setprio(1); \
          \
        if constexpr (F8) { _Pragma("unroll") for (int p_ = 0; p_ < 4; ++p_) _Pragma("unroll") for (int m = 0; m < 4; ++m) _Pragma("unroll") for (int n = 0; n < 2; ++n) { \
            const long a_ = ((long)(unsigned)Bt##8[n][2 * p_ + 1] << 32) | (unsigned)Bt##8[n][2 * p_], b_ = ((long)(unsigned)At##8[m][2 * p_ + 1] << 32) | (unsigned)At##8[m][2 * p_]; \
            asm volatile("v_mfma_f32_16x16x32_fp8_fp8 %0, %1, %2, %0" : "+v"(acc[ai][bj][m][n]) : "v"(a_), "v"(b_)); } }   \
        else { _Pragma("unroll") for (int k = 0; k < 2; ++k) _Pragma("unroll") for (int m = 0; m < 4; ++m) _Pragma("unroll") for (int n = 0; n < 2; ++n) \
            asm volatile("v_mfma_f32_16x16x32_bf16 %0, %1, %2, %0" : "+v"(acc[ai][bj][m][n]) : "v"(Bt[n][k]), "v"(At[m][k])); } \
        __builtin_amdgcn_s_setprio(0); } while (0)
#define PG8_WAIT_V(n) asm volatile("s_waitcnt vmcnt(" #n ")" ::: "memory")
#define PG8_WAIT_VF(SP, LAST) do { if constexpr (Fill::NPT == 2) { if constexpr (SP == 1) asm volatile("s_waitcnt vmcnt(10)" ::: "memory"); else asm volatile("s_waitcnt vmcnt(9)" ::: "memory"); } \
        else if constexpr (Fill::NPT == 1) { if constexpr (LAST) asm volatile("s_waitcnt vmcnt(8)" ::: "memory"); else asm volatile("s_waitcnt vmcnt(9)" ::: "memory"); } \
        else asm volatile("s_waitcnt vmcnt(8)" ::: "memory"); } while (0)
#define PG8_WAIT_L(n) asm volatile("s_waitcnt lgkmcnt(" #n ")" ::: "memory")
#define PG8_BAR __builtin_amdgcn_s_barrier()
#define PG8_SCHED __builtin_amdgcn_sched_barrier(0)
    float fcv[4] = {0.f, 0.f, 0.f, 0.f};
    Unit cur, nxt; int ui = 0; int fi = 0;
    if (!S.next(0, cur)) return;
    f32x4 acc[2][2][4][2];
#pragma unroll
    for (int a = 0; a < 2; ++a)
#pragma unroll
        for (int b = 0; b < 2; ++b)
#pragma unroll
            for (int m = 0; m < 4; ++m)
#pragma unroll
                for (int n = 0; n < 2; ++n) acc[a][b][m][n] = (f32x4){0.f, 0.f, 0.f, 0.f};
    bf16x8 At[4][2], B0[2][2], B1[2][2];
    typedef int v4i_ __attribute__((ext_vector_type(4))); typedef int v8i_ __attribute__((ext_vector_type(8)));
    v8i_ At8[4], B08[2], B18[2];
    unsigned cA = cur.aoff, cB = cur.boff;
    if constexpr (SP2) {
        PG8_STAGEB(PG8_SB(0, 0), cB); PG8_STAGEB(PG8_SB(0, 1), cB + hsB); PG8_STAGEA(PG8_SA(0, 0), cA); PG8_STAGEA(PG8_SA(0, 1), cA + hsA);
        if (wr == 1) PG8_BAR;
        PG8_WAIT_V(2); PG8_BAR;
        PG8_STAGEB(PG8_SB(1, 0), cB + kstep); PG8_STAGEA(PG8_SA(1, 0), cA + kstep); PG8_STAGEB(PG8_SB(1, 1), cB + hsB + kstep);
        PG8_WAIT_V(6); PG8_BAR;
    } else {
        PG8_STAGEB(PG8_SB(0, 0), cB); PG8_STAGEA(PG8_SA(0, 0), cA); PG8_STAGEB(PG8_SB(0, 1), cB + hsB); PG8_STAGEA(PG8_SA(0, 1), cA + hsA);
        if (wr == 1) PG8_BAR;
        PG8_WAIT_V(4); PG8_BAR;
        PG8_STAGEB(PG8_SB(1, 0), cB + kstep); PG8_STAGEA(PG8_SA(1, 0), cA + kstep); PG8_STAGEB(PG8_SB(1, 1), cB + hsB + kstep);
        PG8_WAIT_V(6); PG8_BAR;
    }
    for (;;) {
        const bool has_next = S.next(ui + 1, nxt);
        const unsigned nA = has_next ? nxt.aoff : cA, nB = has_next ? nxt.boff : cB;
        for (int t = 0; t < nt; t += 2) {
            const bool last = (t == nt - 2);
            const unsigned a1 = cA + (unsigned)(t + 1) * kstep;
            const unsigned a2 = last ? nA : cA + (unsigned)(t + 2) * kstep, b2 = last ? nB : cB + (unsigned)(t + 2) * kstep;
            const unsigned a3 = a2 + kstep, b3 = b2 + kstep;
                        if constexpr (SP2) {
            if constexpr (Fill::NPT == 2) F.consume_load(scr, 2 * fi - 2, fcv);
            PG8_LDB(B0, 0, 0); PG8_LDB(B1, 0, 1); PG8_SCHED; PG8_LDA(At, 0, 0); PG8_STAGEA(PG8_SA(1, 1), a1 + hsA);
            if constexpr (Fill::NPT == 2) { F.issue(scr, 2 * fi); F.consume_store(2 * fi - 2, fcv); } else if constexpr (Fill::ON) F.issue(scr, fi);
            PG8_WAIT_VF(1, false); PG8_WAIT_L(0); PG8_BAR; PG8_MMA(0, 0, At, B0); PG8_MMA(0, 1, At, B1); PG8_BAR; PG8_SCHED;
            PG8_LDA(At, 0, 1); PG8_STAGEB(PG8_SB(0, 0), b2); PG8_STAGEB(PG8_SB(0, 1), b2 + hsB); PG8_STAGEA(PG8_SA(0, 0), a2);
            PG8_WAIT_VF(2, false); PG8_WAIT_L(0); PG8_BAR; PG8_MMA(1, 0, At, B0); PG8_MMA(1, 1, At, B1); PG8_BAR; PG8_SCHED;
            if constexpr (Fill::NPT == 2) F.consume_load(scr, 2 * fi - 1, fcv); else if constexpr (Fill::ON) F.consume_load(scr, fi - 1, fcv);
            PG8_LDB(B0, 1, 0); PG8_LDB(B1, 1, 1); PG8_SCHED; PG8_LDA(At, 1, 0); PG8_STAGEA(PG8_SA(0, 1), a2 + hsA);
            if constexpr (Fill::NPT == 2) { F.issue(scr, 2 * fi + 1); F.consume_store(2 * fi - 1, fcv); } else if constexpr (Fill::ON) F.consume_store(fi - 1, fcv);
            PG8_WAIT_VF(1, false); PG8_WAIT_L(0); PG8_BAR; PG8_MMA(0, 0, At, B0); PG8_MMA(0, 1, At, B1); PG8_BAR; PG8_SCHED;
            PG8_LDA(At, 1, 1); PG8_STAGEB(PG8_SB(1, 0), b3); PG8_STAGEB(PG8_SB(1, 1), b3 + hsB); PG8_STAGEA(PG8_SA(1, 0), a3);
            PG8_WAIT_VF(2, true); ++fi; PG8_WAIT_L(0); PG8_BAR; PG8_MMA(1, 0, At, B0); PG8_MMA(1, 1, At, B1); PG8_BAR; PG8_SCHED;
            } else {
            PG8_LDB(B0, 0, 0); PG8_SCHED; PG8_LDA(At, 0, 0); PG8_STAGEA(PG8_SA(1, 1), a1 + hsA);
            PG8_WAIT_L(8); PG8_BAR; PG8_WAIT_L(0); PG8_MMA(0, 0, At, B0); PG8_BAR; PG8_SCHED;
            PG8_LDB(B1, 0, 1); PG8_STAGEB(PG8_SB(0, 0), b2);
            PG8_BAR; PG8_WAIT_L(0); PG8_MMA(0, 1, At, B1); PG8_BAR;
            PG8_LDA(At, 0, 1); PG8_STAGEA(PG8_SA(0, 0), a2);
            PG8_BAR; PG8_WAIT_L(0); PG8_MMA(1, 0, At, B0); PG8_BAR; PG8_SCHED;
            PG8_STAGEB(PG8_SB(0, 1), b2 + hsB);
            PG8_WAIT_V(6); PG8_BAR; PG8_MMA(1, 1, At, B1); PG8_BAR;
            PG8_LDB(B0, 1, 0); PG8_SCHED; PG8_LDA(At, 1, 0); PG8_STAGEA(PG8_SA(0, 1), a2 + hsA);
            PG8_WAIT_L(8); PG8_BAR; PG8_WAIT_L(0); PG8_MMA(0, 0, At, B0); PG8_BAR; PG8_SCHED;
            PG8_LDB(B1, 1, 1); PG8_STAGEB(PG8_SB(1, 0), b3);
            PG8_BAR; PG8_WAIT_L(0); PG8_MMA(0, 1, At, B1); PG8_BAR;
            PG8_LDA(At, 1, 1); PG8_STAGEA(PG8_SA(1, 0), a3);
            PG8_BAR; PG8_WAIT_L(0); PG8_MMA(1, 0, At, B0); PG8_BAR; PG8_SCHED;
            PG8_STAGEB(PG8_SB(1, 1), b3 + hsB);
            PG8_WAIT_V(6); PG8_BAR; PG8_MMA(1, 1, At, B1); PG8_BAR;
            }
        }
        if constexpr (ALIGN_EPI) { if (wr == 0) PG8_BAR; }
        asm volatile("s_nop 15\n\ts_nop 15" ::: "memory");
        E(acc, cur, wr, wc, fr, fq);
        if (!has_next) break;
        if (!E.keep(cur)) {
#pragma unroll
        for (int a = 0; a < 2; ++a)
#pragma unroll
            for (int b = 0; b < 2; ++b)
#pragma unroll
                for (int m = 0; m < 4; ++m)
#pragma unroll
                    for (int n = 0; n < 2; ++n) acc[a][b][m][n] = (f32x4){0.f, 0.f, 0.f, 0.f};
        }
        cur = nxt; cA = nA; cB = nB; ++ui;
        if constexpr (ALIGN_EPI) { if (wr == 1) PG8_BAR; }
    }
    PG8_WAIT_V(0);
    if constexpr (!ALIGN_EPI) { if (wr == 0) PG8_BAR; }
    PG8_BAR;
    if constexpr (Fill::NPT == 2) { F.consume_load(scr, 2 * fi - 2, fcv); F.consume_store(2 * fi - 2, fcv); F.consume_load(scr, 2 * fi - 1, fcv); F.consume_store(2 * fi - 1, fcv); }
    else if constexpr (Fill::ON) { F.consume_load(scr, fi - 1, fcv); F.consume_store(fi - 1, fcv); }
#undef PG8_SA
#undef PG8_SB
#undef PG8_STAGE_
#undef PG8_STAGEA
#undef PG8_STAGEB
#undef PG8_LDA
#undef PG8_LDB
#undef PG8_MMA
#undef PG8_WAIT_V
#undef PG8_WAIT_L
#undef PG8_WAIT_VF
#undef PG8_BAR
#undef PG8_SCHED
}
}


namespace pg8 {
struct SchedPlain {
    int nM, nN, G, c, lda, ldb;
    __device__ __forceinline__ bool next(int i, Unit& u) const {
        const int L = i * G + c; if (L >= nM * nN) return false;
        tile_of(L, nM, nN, u.pm, u.pn); u.kh = 0; u.aoff = (unsigned)u.pm * BM * lda * 2u; u.boff = (unsigned)u.pn * BM * ldb * 2u; return true; }
};
struct SchedIn {
    int G, c;
    __device__ __forceinline__ bool next(int i, Unit& u) const {
        const int L = i * G + c; if (L >= 32 * 16) return false;
        int pn; tile_of(L, 32, 16, u.pm, pn); if (pn >= 8) pn += 8; u.pn = pn; u.kh = 0; u.aoff = (unsigned)u.pm * BM * 4096 * 2u; u.boff = (unsigned)pn * BM * 4096 * 2u; return true; }
};
struct SchedUp {
    int G, c;
    __device__ __forceinline__ bool next(int i, Unit& u) const {
        const int L = (i >> 1) * G + c; if (L >= 32 * 16) return false;
        tile_of(L, 32, 16, u.pm, u.pn); u.kh = i & 1; u.aoff = ((unsigned)u.pm * BM * 4096 + (unsigned)u.kh * 2048) * 2u; u.boff = ((unsigned)u.pn * BM * 4096 + (unsigned)u.kh * 2048) * 2u; return true; }
};
struct SchedPool {
    int G, c;
    __device__ __forceinline__ bool next(int i, Unit& u) const {
        const int L = i * G + c; if (L >= 32 * 8) return false;
        tile_of(L, 32, 8, u.pm, u.pn); u.kh = 0; u.aoff = ((unsigned)u.pm * BM * 2048 + (unsigned)(u.pn >> 1) * 512) * 2u; u.boff = (unsigned)u.pn * BM * 512 * 2u; return true; }
};

struct PickP2 {
    const float* iWa; const float* iWb; const float* iWo; const float* iWf; unsigned oUp, oOut, oF1;
    __device__ __forceinline__ void operator()(int I, const float*& iw, unsigned& ot, int& s, int& l, int& k, int& idx) const {
        l = 4096; s = 7; k = 0;
        if (I < 4096) { iw = iWa; ot = oUp; idx = I; } else if (I < 8192) { iw = iWb; ot = oUp; k = 2048; idx = I - 4096; }
        else if (I < 16384) { iw = iWo; ot = oOut; idx = I - 8192; } else { iw = iWf; ot = oF1; s = 9; idx = I - 16384; }
    }
};
struct PickFF2 {
    const float* iW; unsigned oT;
    __device__ __forceinline__ void operator()(int I, const float*& iw, unsigned& ot, int& s, int& l, int& k, int& idx) const { iw = iW; ot = oT; s = 7; l = 16384; k = 0; idx = I; }
};
template <class Pick, int NPT_ = 1> struct FillConv {
    static constexpr bool ON = true; static constexpr int NPT = NPT_;
    __device__ __forceinline__ static unsigned slot(int i) { return NPT_ == 2 ? ((unsigned)(i + 3) % 3u) * 8192u : (unsigned)(i & 1) * 8192u; }
    Pick pick; int base, G, c; unsigned char* ws; PG8_LAS unsigned char* ptab; unsigned odump;
    __device__ __forceinline__ const float* inp(int k) const { volatile PG8_LAS unsigned* t = (volatile PG8_LAS unsigned*)ptab + 2 * k;
        const unsigned lo = __builtin_amdgcn_readfirstlane(t[0]), hi = __builtin_amdgcn_readfirstlane(t[1]); return (const float*)(((unsigned long long)hi << 32) | lo); }
    __device__ __forceinline__ void issue(PG8_LAS unsigned char* scr, int i) const {
        const float* Wp; int s, l, ko_, idx; unsigned ot; pick(base + i * G + c, Wp, ot, s, l, ko_, idx);
        const int kb = idx >> s, nb = idx & ((1 << s) - 1);
        int tid = threadIdx.x; asm volatile("" : "+v"(tid));
        const int k = tid >> 3, cc = (tid & 7) ^ ((k >> 3) & 7);
        const unsigned voff = (unsigned)(k << (s + 5)) * 4u + (unsigned)cc * 16u;
        const char* src = (const char*)(Wp + ((size_t)(64 * kb) << (s + 5)) + 32 * nb) + voff;
        __builtin_amdgcn_global_load_lds((const unsigned*)src, (PG8_LAS unsigned*)(scr + slot(i) + __builtin_amdgcn_readfirstlane(tid >> 6) * 1024), 16, 0, 0);
    }
    __device__ __forceinline__ void consume_load(PG8_LAS unsigned char* scr, int i, float (&v)[4]) const {
        int tid = threadIdx.x; asm volatile("" : "+v"(tid));
        const int n = tid >> 4, kq = tid & 15;
        const PG8_LAS float* p = (const PG8_LAS float*)(scr + slot(i) + (4 * kq) * 128 + (((n >> 2) ^ (kq >> 1)) * 16) + (n & 3) * 4);
        v[0] = p[0]; v[1] = p[32]; v[2] = p[64]; v[3] = p[96];
    }
    __device__ __forceinline__ void consume_store(int i, const float (&v)[4]) const {
        int tid = threadIdx.x; asm volatile("" : "+v"(tid));
        const int n = tid >> 4, kq = tid & 15;
        u32x2 o; o.x = cvt_pk_bf16(v[0], v[1]); o.y = cvt_pk_bf16(v[2], v[3]);
        const float* Wp; int s, l, ko_, idx; unsigned ot; pick(base + (i < 0 ? 0 : i) * G + c, Wp, ot, s, l, ko_, idx);
        const int kb = idx >> s, nb = idx & ((1 << s) - 1);
        const unsigned voff = ((unsigned)n * (unsigned)l + 4u * (unsigned)kq) * 2u;
        char* dst = (char*)((bf16_t*)(ws + ((size_t)ot << 20)) + (size_t)(32 * nb) * l + ko_ + 64 * kb) + voff;
        if (i < 0) dst = (char*)(ws + odump) + tid * 8;
        *(u32x2*)dst = o;
    }
};
#define PG8_EPI_COMMON static constexpr bool PERM = true; __device__ __forceinline__ bool keep(const Unit&) const { return false; }

struct EpiIn {
    PG8_EPI_COMMON
    unsigned char* ws; unsigned oU, oP, oGT; const float* bgate;
    __device__ __forceinline__ void operator()(f32x4 (&acc)[2][2][4][2], const Unit& u, int wr, int wc, int fr, int fq) const {
        asm volatile("" : "+v"(fr), "+v"(fq));
        const int pn = u.pn; const bool isU = pn < 8, isP = (pn >= 16 && pn < 24), isG = pn >= 24;
        bf16_t* base; int ld;
        if (isU) { base = (bf16_t*)(ws + ((size_t)oU << 20)) + pn * 256; ld = 2048; } else if (isP) { base = (bf16_t*)(ws + ((size_t)oP << 20)) + (pn - 16) * 256; ld = 2048; } else { base = (bf16_t*)(ws + ((size_t)oGT << 20)) + (pn - 24) * 256; ld = 8192; }
        const int row0 = u.pm * BM + wr * 64 + fr, col0 = wc * 32 + 8 * fq;
        const float kA = isU ? 1.5957691216f : 1.0f, kB = isU ? 0.0713548163f : 0.0f;
        f32x4 bv[2][2];
#pragma unroll
        for (int bj = 0; bj < 2; ++bj)
#pragma unroll
            for (int n = 0; n < 2; ++n) bv[bj][n] = isG ? *(const f32x4*)(bgate + (pn - 24) * 256 + col0 + bj * HALF + 4 * n) : (f32x4){0.f, 0.f, 0.f, 0.f};
#pragma unroll
        for (int ai = 0; ai < 2; ++ai)
#pragma unroll
            for (int m = 0; m < 4; ++m) { bf16_t* rowp = base + (size_t)(row0 + ai * HALF + m * 16) * ld + col0;
#pragma unroll
                for (int bj = 0; bj < 2; ++bj) { float o[8];
#pragma unroll
                    for (int e = 0; e < 8; ++e) { const float v = acc[ai][bj][m][e >> 2][e & 3] + bv[bj][e >> 2][e & 3];
                        const float z = v * (kA + kB * v * v); const float s = __builtin_amdgcn_rcpf(1.0f + __builtin_amdgcn_exp2f(-1.4426950409f * z));
                        const float a = isG ? 1.0f : v; o[e] = isP ? v : a * s; }
                    u32x4 w; w.x = cvt_pk_bf16(o[0], o[1]); w.y = cvt_pk_bf16(o[2], o[3]); w.z = cvt_pk_bf16(o[4], o[5]); w.w = cvt_pk_bf16(o[6], o[7]);
                    *(u32x4*)(rowp + bj * HALF) = w; } }
    }
};
struct EpiGate {
    PG8_EPI_COMMON
    bf16_t* GT; const float* bgate; float sc;
    __device__ __forceinline__ void operator()(f32x4 (&acc)[2][2][4][2], const Unit& u, int wr, int wc, int fr, int fq) const {
        asm volatile("" : "+v"(fr), "+v"(fq));
        const int row0 = u.pm * BM + wr * 64 + fr, col0 = u.pn * BM + wc * 32 + 8 * fq;
        f32x4 bv[2][2];
#pragma unroll
        for (int bj = 0; bj < 2; ++bj)
#pragma unroll
            for (int n = 0; n < 2; ++n) bv[bj][n] = *(const f32x4*)(bgate + col0 + bj * HALF + 4 * n);
#pragma unroll
        for (int ai = 0; ai < 2; ++ai)
#pragma unroll
            for (int m = 0; m < 4; ++m) { bf16_t* rowp = GT + (size_t)(row0 + ai * HALF + m * 16) * 8192 + col0;
#pragma unroll
                for (int bj = 0; bj < 2; ++bj) { float o[8];
#pragma unroll
                    for (int e = 0; e < 8; ++e) { const float z = acc[ai][bj][m][e >> 2][e & 3] * sc + bv[bj][e >> 2][e & 3];
                        o[e] = __builtin_amdgcn_rcpf(1.0f + __builtin_amdgcn_exp2f(-1.4426950409f * z)); }
                    u32x4 w; w.x = cvt_pk_bf16(o[0], o[1]); w.y = cvt_pk_bf16(o[2], o[3]); w.z = cvt_pk_bf16(o[4], o[5]); w.w = cvt_pk_bf16(o[6], o[7]);
                    *(u32x4*)(rowp + bj * HALF) = w; } }
    }
};
struct EpiVT {
    PG8_EPI_COMMON
    bf16_t* VT; f32x2* stats;
    __device__ __forceinline__ void operator()(f32x4 (&acc)[2][2][4][2], const Unit& u, int wr, int wc, int fr, int fq) const {
        asm volatile("" : "+v"(fr), "+v"(fq));
        const int row0 = u.pm * BM + wr * 64 + fr, col0 = u.pn * BM + wc * 32 + 8 * fq;
#pragma unroll
        for (int bj = 0; bj < 2; ++bj) {
            float s1[8], s2[8];
#pragma unroll
            for (int e = 0; e < 8; ++e) { s1[e] = 0.f; s2[e] = 0.f; }
#pragma unroll
            for (int ai = 0; ai < 2; ++ai)
#pragma unroll
                for (int m = 0; m < 4; ++m) { bf16_t* rowp = VT + (size_t)(row0 + ai * HALF + m * 16) * 8192 + col0 + bj * HALF; float o[8];
#pragma unroll
                    for (int e = 0; e < 8; ++e) { const float v = acc[ai][bj][m][e >> 2][e & 3];
                        const float z = v * (1.5957691216f + 0.0713548163f * v * v); const float s = __builtin_amdgcn_rcpf(1.0f + __builtin_amdgcn_exp2f(-1.4426950409f * z));
                        o[e] = v * s; s1[e] += o[e]; s2[e] += o[e] * o[e]; }
                    u32x4 w; w.x = cvt_pk_bf16(o[0], o[1]); w.y = cvt_pk_bf16(o[2], o[3]); w.z = cvt_pk_bf16(o[4], o[5]); w.w = cvt_pk_bf16(o[6], o[7]);
                    *(u32x4*)(rowp) = w; }
#pragma unroll
            for (int e = 0; e < 8; ++e) {
#pragma unroll
                for (int o = 1; o < 16; o <<= 1) { s1[e] += __shfl_xor(s1[e], o); s2[e] += __shfl_xor(s2[e], o); } }
            if (fr == 0) {
#pragma unroll
                for (int e = 0; e < 8; ++e) stats[(size_t)(col0 + bj * HALF + e) * 16 + u.pm * 2 + wr] = (f32x2){s1[e], s2[e]}; }
            asm volatile("" ::: "memory");
        }
    }
};
struct EpiUp {
    static constexpr bool PERM = true;
    __device__ __forceinline__ bool keep(const Unit& u) const { return u.kh == 0; }
    const bf16_t* GT; bf16_t* O;
    __device__ __forceinline__ void operator()(f32x4 (&acc)[2][2][4][2], const Unit& u, int wr, int wc, int fr, int fq) const {
        asm volatile("" : "+v"(fr), "+v"(fq));
        const int row0 = u.pm * BM + wr * 64 + fr, col0 = u.pn * BM + wc * 32 + 8 * fq;
        if (u.kh == 0) {
#pragma unroll
            for (int ai = 0; ai < 2; ++ai)
#pragma unroll
                for (int m = 0; m < 4; ++m) { const bf16_t* gp = GT + (size_t)(row0 + ai * HALF + m * 16) * 8192 + col0;
#pragma unroll
                    for (int bj = 0; bj < 2; ++bj) { const u32x4 ga = *(const u32x4*)(gp + bj * HALF), gb = *(const u32x4*)(gp + 4096 + bj * HALF);
#pragma unroll
                        for (int q = 0; q < 4; ++q) { const float r0 = bf_lo(ga[q]) * __builtin_amdgcn_rcpf(bf_lo(gb[q])), r1 = bf_hi(ga[q]) * __builtin_amdgcn_rcpf(bf_hi(gb[q]));
                            acc[ai][bj][m][q >> 1][(q & 1) * 2] *= r0; acc[ai][bj][m][q >> 1][(q & 1) * 2 + 1] *= r1; } } }
        } else {
#pragma unroll
            for (int ai = 0; ai < 2; ++ai)
#pragma unroll
                for (int m = 0; m < 4; ++m) { const size_t r = (size_t)(row0 + ai * HALF + m * 16); const bf16_t* gp = GT + r * 8192 + 4096 + col0; bf16_t* op = O + r * 4096 + col0;
#pragma unroll
                    for (int bj = 0; bj < 2; ++bj) { const u32x4 gb = *(const u32x4*)(gp + bj * HALF); u32x4 w;
#pragma unroll
                        for (int q = 0; q < 4; ++q) w[q] = cvt_pk_bf16(acc[ai][bj][m][q >> 1][(q & 1) * 2] * bf_lo(gb[q]), acc[ai][bj][m][q >> 1][(q & 1) * 2 + 1] * bf_hi(gb[q]));
                        *(u32x4*)(op + bj * HALF) = w; } }
        }
    }
};
template <bool XBF, bool OBF> struct EpiRes {
    PG8_EPI_COMMON
    const void* X; const float* gate; void* O;
    static __device__ __forceinline__ f32x4 up_lo(u32x4 w) { return (f32x4){__uint_as_float(w.x << 16), __uint_as_float(w.x & 0xffff0000u), __uint_as_float(w.y << 16), __uint_as_float(w.y & 0xffff0000u)}; }
    static __device__ __forceinline__ f32x4 up_hi(u32x4 w) { return (f32x4){__uint_as_float(w.z << 16), __uint_as_float(w.z & 0xffff0000u), __uint_as_float(w.w << 16), __uint_as_float(w.w & 0xffff0000u)}; }
    __device__ __forceinline__ void operator()(f32x4 (&acc)[2][2][4][2], const Unit& u, int wr, int wc, int fr, int fq) const {
        asm volatile("" : "+v"(fr), "+v"(fq));
        const int row0 = u.pm * BM + wr * 64 + fr, col0 = u.pn * BM + wc * 32 + 8 * fq;
        f32x4 gv[2][2];
#pragma unroll
        for (int bj = 0; bj < 2; ++bj)
#pragma unroll
            for (int n = 0; n < 2; ++n) gv[bj][n] = *(const f32x4*)(gate + col0 + bj * HALF + 4 * n);
        f32x4 xv[2][2], xn[2][2]; u32x4 bv[2], bn[2];
        { const size_t off = (size_t)row0 * 4096 + col0;
#pragma unroll
          for (int bj = 0; bj < 2; ++bj) { if constexpr (XBF) bv[bj] = *(const u32x4*)((const bf16_t*)X + off + bj * HALF);
              else {
#pragma unroll
                  for (int n = 0; n < 2; ++n) xv[bj][n] = *(const f32x4*)((const float*)X + off + bj * HALF + 4 * n); } } }
#pragma unroll
        for (int g = 0; g < 8; ++g) { const int ai = g >> 2, m = g & 3;
            if (g + 1 < 8) { const size_t offn = (size_t)(row0 + ((g + 1) >> 2) * HALF + ((g + 1) & 3) * 16) * 4096 + col0;
#pragma unroll
                for (int bj = 0; bj < 2; ++bj) { if constexpr (XBF) bn[bj] = *(const u32x4*)((const bf16_t*)X + offn + bj * HALF);
                    else {
#pragma unroll
                        for (int n = 0; n < 2; ++n) xn[bj][n] = *(const f32x4*)((const float*)X + offn + bj * HALF + 4 * n); } } }
            const size_t off = (size_t)(row0 + ai * HALF + m * 16) * 4096 + col0;
#pragma unroll
            for (int bj = 0; bj < 2; ++bj) {
                f32x4 r0, r1;
                if constexpr (XBF) { r0 = up_lo(bv[bj]); r1 = up_hi(bv[bj]); } else { r0 = xv[bj][0]; r1 = xv[bj][1]; }
                r0 = r0 + gv[bj][0] * acc[ai][bj][m][0]; r1 = r1 + gv[bj][1] * acc[ai][bj][m][1];
                if constexpr (OBF) { u32x4 w; w.x = cvt_pk_bf16(r0.x, r0.y); w.y = cvt_pk_bf16(r0.z, r0.w); w.z = cvt_pk_bf16(r1.x, r1.y); w.w = cvt_pk_bf16(r1.z, r1.w);
                    *(u32x4*)((bf16_t*)O + off + bj * HALF) = w; }
                else { *(f32x4*)((float*)O + off + bj * HALF) = r0; *(f32x4*)((float*)O + off + bj * HALF + 4) = r1; } }
#pragma unroll
            for (int bj = 0; bj < 2; ++bj) { if constexpr (XBF) bv[bj] = bn[bj]; else {
#pragma unroll
                for (int n = 0; n < 2; ++n) xv[bj][n] = xn[bj][n]; } }
        }
    }
};
struct EpiFF1 {
    PG8_EPI_COMMON
    bf16_t* O;
    __device__ __forceinline__ void operator()(f32x4 (&acc)[2][2][4][2], const Unit& u, int wr, int wc, int fr, int fq) const {
        asm volatile("" : "+v"(fr), "+v"(fq));
        const int row0 = u.pm * BM + wr * 64 + fr, col0 = u.pn * BM + wc * 32 + 8 * fq;
#pragma unroll
        for (int ai = 0; ai < 2; ++ai)
#pragma unroll
            for (int m = 0; m < 4; ++m) { bf16_t* rowp = O + (size_t)(row0 + ai * HALF + m * 16) * 16384 + col0;
#pragma unroll
                for (int bj = 0; bj < 2; ++bj) { float o[8];
#pragma unroll
                    for (int e = 0; e < 8; ++e) { const float v = fmaxf(acc[ai][bj][m][e >> 2][e & 3], 0.f); o[e] = v * v; }
                    u32x4 w; w.x = cvt_pk_bf16(o[0], o[1]); w.y = cvt_pk_bf16(o[2], o[3]); w.z = cvt_pk_bf16(o[4], o[5]); w.w = cvt_pk_bf16(o[6], o[7]);
                    *(u32x4*)(rowp + bj * HALF) = w; } }
    }
};
struct EpiPool {
    PG8_EPI_COMMON
    bf16_t* O; const float* bias; const float* scale;
    __device__ __forceinline__ void operator()(f32x4 (&acc)[2][2][4][2], const Unit& u, int wr, int wc, int fr, int fq) const {
        asm volatile("" : "+v"(fr), "+v"(fq));
        const int row0 = u.pm * BM + wr * 64 + fr, col0 = u.pn * BM + wc * 32 + 8 * fq;
        f32x4 bv[2][2], sv[2][2];
#pragma unroll
        for (int bj = 0; bj < 2; ++bj)
#pragma unroll
            for (int n = 0; n < 2; ++n) { bv[bj][n] = *(const f32x4*)(bias + col0 + bj * HALF + 4 * n); sv[bj][n] = *(const f32x4*)(scale + col0 + bj * HALF + 4 * n); }
#pragma unroll
        for (int ai = 0; ai < 2; ++ai)
#pragma unroll
            for (int m = 0; m < 4; ++m) { bf16_t* rowp = O + (size_t)(row0 + ai * HALF + m * 16) * 4096 + 2048 + col0;
#pragma unroll
                for (int bj = 0; bj < 2; ++bj) { const f32x4 v0 = (acc[ai][bj][m][0] + bv[bj][0]) * sv[bj][0], v1 = (acc[ai][bj][m][1] + bv[bj][1]) * sv[bj][1];
                    u32x4 w; w.x = cvt_pk_bf16(v0[0], v0[1]); w.y = cvt_pk_bf16(v0[2], v0[3]); w.z = cvt_pk_bf16(v1[0], v1[1]); w.w = cvt_pk_bf16(v1[2], v1[3]);
                    *(u32x4*)(rowp + bj * HALF) = w; } }
    }
};
}

constexpr int NWAVES = 8;
#ifndef MK_PER_PHASE
#define MK_PER_PHASE 0
#endif
#ifndef MK_FILL
#define MK_FILL 0
#endif
#ifndef PG8_SP2
#define PG8_SP2 true
#endif
#ifndef PG8_ALIGN
#define PG8_ALIGN true
#endif
constexpr int N_PHASES = 11;
constexpr int SEQ = 8192, DM = 4096, DA = 2048, DB = 2048, DFF = 16384, INC = 14336, NMODV = 6 * 4096;
constexpr int NH = 16, HD = 128, CHK = 128, NCHUNK = SEQ / CHK;
constexpr float EPS = 1e-6f;

constexpr size_t MiB = 1u << 20;
constexpr bool X1_BF16 = true, X2_BF16 = true;
constexpr size_t WS_CTL = 0, CTL_ZERO_BYTES = 64 * 1024;
constexpr size_t WS_MOD = 1 * MiB;
constexpr size_t WS_STATS = 2 * MiB;
constexpr size_t WS_DUMP = 1 * MiB + 512 * 1024;
constexpr size_t WS_WSP = 3 * MiB;
constexpr size_t WS_WPOOL = 4 * MiB;
constexpr size_t WS_WIN = 8 * MiB;
constexpr size_t WS_WUP = WS_WIN + 112 * MiB;
constexpr size_t WS_WOUT = WS_WUP + 32 * MiB;
constexpr size_t WS_WFF1 = WS_WOUT + 32 * MiB;
constexpr size_t WS_WFF2 = WS_WFF1 + 128 * MiB;
constexpr size_t WS_H = WS_WFF2 + 128 * MiB;
constexpr size_t WS_U = WS_H + 64 * MiB;
constexpr size_t WS_VT = WS_U + 32 * MiB;
constexpr size_t WS_P = WS_VT + 32 * MiB;
constexpr size_t WS_GT = WS_P + 32 * MiB;
constexpr size_t WS_ACAT = WS_GT + 128 * MiB;
constexpr size_t WS_POOLED = WS_ACAT + 64 * MiB;
constexpr size_t WS_MERGED = WS_POOLED + 32 * MiB;
constexpr size_t WS_X1 = WS_MERGED + 64 * MiB;
constexpr size_t WS_HID = WS_X1 + 128 * MiB;
constexpr size_t WS_H8 = WS_HID + 256 * MiB;
constexpr size_t WS_W8 = WS_H8 + 32 * MiB;
constexpr size_t WS_END = WS_W8 + 32 * MiB;
constexpr float W8_SCALE = 64.0f;
constexpr int CW_BAR = 0;
constexpr int RING_OFF = 0, RING_BYTES = 131072;
constexpr int LDSCTL_OFF = RING_BYTES, MISC_OFF = LDSCTL_OFF + 320;
constexpr int PTAB_OFF = RING_BYTES + 512;
constexpr int SCR_OFF = RING_BYTES + 1024, SCR_BYTES = 24576;
constexpr int LDS_BYTES = 156672;

#define GAS __attribute__((address_space(1)))
#define LAS __attribute__((address_space(3)))
typedef unsigned short bf16;
typedef unsigned v4u __attribute__((ext_vector_type(4)));
typedef unsigned v2u __attribute__((ext_vector_type(2)));
typedef float f32x4 __attribute__((ext_vector_type(4)));
typedef float f32x2 __attribute__((ext_vector_type(2)));
typedef short bf16x8 __attribute__((ext_vector_type(8)));
typedef GAS unsigned gu32;
#define RLX_AGENT __ATOMIC_RELAXED, __HIP_MEMORY_SCOPE_AGENT
#define LDS_WAIT() asm volatile("s_waitcnt lgkmcnt(0)" ::: "memory")
#define VM_WAIT() asm volatile("s_waitcnt vmcnt(0)" ::: "memory")
__device__ __forceinline__ unsigned f2bf(float f) { unsigned u = __builtin_bit_cast(unsigned, f); return (u + 0x7fffu + ((u >> 16) & 1u)) >> 16; }
__device__ __forceinline__ unsigned pk2(float lo, float hi) { return f2bf(lo) | (f2bf(hi) << 16); }
__device__ __forceinline__ float bflo(unsigned w) { return __uint_as_float(w << 16); }
__device__ __forceinline__ float bfhi(unsigned w) { return __uint_as_float(w & 0xffff0000u); }

#define XB_TMO      128
#define XB_XCNT(j)  (256  + 64 * (j))
#define XB_XSUB(j)  (1280 + 64 * (j))
#define XB_XGEN(j)  (2304 + 64 * (j))
#define XB_TOP      3328
#define XB_TOPGEN   3392
#define XCD_BAR_WORDS 3456
#define XB_SPIN_CAP (1u << 18)

__device__ __forceinline__ unsigned xb_ld(unsigned* p)              { return __hip_atomic_load(p, __ATOMIC_RELAXED, __HIP_MEMORY_SCOPE_AGENT); }
__device__ __forceinline__ unsigned xb_add(unsigned* p, unsigned v) { return __hip_atomic_fetch_add(p, v, __ATOMIC_RELAXED, __HIP_MEMORY_SCOPE_AGENT); }
__device__ __forceinline__ unsigned xb_xcc_id() { return (unsigned)__builtin_amdgcn_s_getreg((3 << 11) | 20) & 0xFu; }
#define XB_SPIN(cond, bar) do { unsigned _sp = 0; while (cond) { __builtin_amdgcn_s_sleep(1); \
    if ((++_sp & 255u) == 0u) { if (xb_ld(&(bar)[XB_TMO])) break; if (_sp > XB_SPIN_CAP) { atomicAdd(&(bar)[XB_TMO], 1u); break; } } } } while (0)

struct XcdBarrier {
    unsigned* bar; unsigned x;
    volatile LAS unsigned* st;
};

__device__ __forceinline__ XcdBarrier xcd_barrier_post(unsigned* bar, volatile LAS unsigned* st) {
    XcdBarrier b; b.bar = bar; b.x = xb_xcc_id(); b.st = st;
    if (threadIdx.x == 0) (void)xb_add(&bar[XB_XCNT(b.x)], 1u);
    return b;
}
__device__ __forceinline__ void xcd_barrier_complete(unsigned* bar, unsigned x, unsigned& nloc, unsigned& nx) {
    const unsigned G = gridDim.x * gridDim.y * gridDim.z;
    unsigned sum, cnt, mine, sp = 0u;
    for (;;) {
        sum = 0u; cnt = 0u; mine = 0u;
#pragma unroll
        for (unsigned j = 0; j < 16; ++j) { const unsigned c = xb_ld(&bar[XB_XCNT(j)]); sum += c; cnt += (c > 0u) ? 1u : 0u; mine = (j == x) ? c : mine; }
        if (sum == G) break;
        __builtin_amdgcn_s_sleep(1);
        if ((++sp & 255u) == 0u) { if (xb_ld(&bar[XB_TMO])) break; if (sp > XB_SPIN_CAP) { atomicAdd(&bar[XB_TMO], 1u); break; } }
    }
    nloc = mine > 0u ? mine : 1u; nx = cnt > 0u ? cnt : 1u;
}

__device__ __forceinline__ void xcd_barrier(const XcdBarrier& b) {
    asm volatile("s_waitcnt vmcnt(0)" ::: "memory");
    __syncthreads();
    if (threadIdx.x == 0) {
        unsigned* bar = b.bar;
        __builtin_amdgcn_s_waitcnt(0);
        unsigned nloc = b.st[0], nx = b.st[1];
        if (nloc == 0u) { xcd_barrier_complete(bar, b.x, nloc, nx); b.st[0] = nloc; b.st[1] = nx; }
        const unsigned old = xb_add(&bar[XB_XSUB(b.x)], 1u);
        const unsigned gen = old / nloc;
        if (old + 1u == (gen + 1u) * nloc) {
            __builtin_amdgcn_fence(__ATOMIC_RELEASE, "agent");
            asm volatile("s_waitcnt vmcnt(0)" ::: "memory");
            const unsigned og = xb_add(&bar[XB_TOP], 1u);
            const unsigned tg = og / nx;
            if (og + 1u == (tg + 1u) * nx) xb_add(&bar[XB_TOPGEN], 1u);
            else XB_SPIN(xb_ld(&bar[XB_TOPGEN]) == tg, bar);
            __builtin_amdgcn_fence(__ATOMIC_ACQUIRE, "agent");
            xb_add(&bar[XB_XGEN(b.x)], 1u);
            asm volatile("s_waitcnt vmcnt(0)" ::: "memory");
        } else {
            XB_SPIN(xb_ld(&bar[XB_XGEN(b.x)]) == gen, bar);
            __builtin_amdgcn_fence(__ATOMIC_ACQUIRE, "agent");
            asm volatile("s_waitcnt vmcnt(0)" ::: "memory");
        }
    }
    __syncthreads();
}

struct Ctx {
    LAS unsigned char* lds;
    int tid, lane, wave, G;
    unsigned char* ws;
};
enum { IN_x, IN_c, IN_w_ada, IN_b_ada, IN_norm1_g, IN_w_in, IN_ln_v_g, IN_ln_v_b, IN_w_spatial, IN_b_spatial, IN_w_pool, IN_b_pool, IN_pool_scale, IN_b_gate, IN_w_up_a, IN_w_up_b, IN_w_out, IN_norm2_g, IN_w_ff1, IN_w_ff2, IN_norm_f_g, IN_out, IN_COUNT };
__device__ __forceinline__ float* ioptr(const Ctx& C, int k) {
    volatile LAS unsigned* t = (volatile LAS unsigned*)(C.lds + PTAB_OFF) + 2 * k;
    const unsigned lo = __builtin_amdgcn_readfirstlane(t[0]), hi = __builtin_amdgcn_readfirstlane(t[1]);
    return (float*)(((unsigned long long)hi << 32) | lo);
}
#define INP(name) ((const float*)ioptr(C, IN_##name))
#define OUTP ioptr(C, IN_out)
__device__ __forceinline__ float wave_sum(float v) {
#pragma unroll
    for (int o = 1; o < 64; o <<= 1) v += __shfl_xor(v, o);
    return v;
}
__device__ __forceinline__ void p0_transpose_item(const float* W, int N, bf16* WT, int ldk, int row_off, int k_off, LAS float* scr, int item, int lane) {
    const int nblk = N / 32, kb = item / nblk, nb = item % nblk, k0 = 64 * kb, n0 = 32 * nb;
    float wv[32];
#pragma unroll
    for (int i = 0; i < 32; ++i) wv[i] = __builtin_nontemporal_load(W + (size_t)(k0 + 2 * i + (lane >> 5)) * N + n0 + (lane & 31));
#pragma unroll
    for (int i = 0; i < 32; ++i) scr[(2 * i + (lane >> 5)) * 33 + (lane & 31)] = wv[i];
    LDS_WAIT(); asm volatile("" ::: "memory");
    const int c = lane & 7;
#pragma unroll
    for (int j = 0; j < 4; ++j) { const int n = (lane >> 3) + 8 * j; const LAS float* s = scr + (8 * c) * 33 + n;
        v4u o; o.x = pk2(s[0 * 33], s[1 * 33]); o.y = pk2(s[2 * 33], s[3 * 33]); o.z = pk2(s[4 * 33], s[5 * 33]); o.w = pk2(s[6 * 33], s[7 * 33]);
        *(GAS v4u*)(WT + (size_t)(row_off + n0 + n) * ldk + k_off + k0 + 8 * c) = o; }
    LDS_WAIT(); asm volatile("" ::: "memory");
}
__device__ __forceinline__ void p0_transpose_item_f8(const float* W, int N, unsigned char* WT, int ldk, int row_off, float sc, LAS float* scr, int item, int lane) {
    const int nblk = N / 32, kb = item / nblk, nb = item % nblk, k0 = 64 * kb, n0 = 32 * nb;
    float wv[32];
#pragma unroll
    for (int i = 0; i < 32; ++i) wv[i] = __builtin_nontemporal_load(W + (size_t)(k0 + 2 * i + (lane >> 5)) * N + n0 + (lane & 31));
#pragma unroll
    for (int i = 0; i < 32; ++i) scr[(2 * i + (lane >> 5)) * 33 + (lane & 31)] = wv[i];
    LDS_WAIT(); asm volatile("" ::: "memory");
    const int c = lane & 7;
#pragma unroll
    for (int j = 0; j < 4; ++j) { const int n = (lane >> 3) + 8 * j; const LAS float* s = scr + (8 * c) * 33 + n;
        int d0 = __builtin_amdgcn_cvt_pk_fp8_f32(s[0 * 33] * sc, s[1 * 33] * sc, 0, false); d0 = __builtin_amdgcn_cvt_pk_fp8_f32(s[2 * 33] * sc, s[3 * 33] * sc, d0, true);
        int d1 = __builtin_amdgcn_cvt_pk_fp8_f32(s[4 * 33] * sc, s[5 * 33] * sc, 0, false); d1 = __builtin_amdgcn_cvt_pk_fp8_f32(s[6 * 33] * sc, s[7 * 33] * sc, d1, true);
        *(GAS v2u*)(WT + (size_t)(row_off + n0 + n) * ldk + k0 + 8 * c) = (v2u){(unsigned)d0, (unsigned)d1}; }
    LDS_WAIT(); asm volatile("" ::: "memory");
}
__device__ __forceinline__ void p0_prologue(Ctx& C) {
    {
        LAS float* cact = (LAS float*)(C.lds);
        LAS float* red = (LAS float*)(C.lds + 16384);
        for (int i = C.tid; i < DM; i += NWAVES * 64) { const float v = INP(c)[i]; cact[i] = v / (1.0f + __expf(-v)); }
        __syncthreads();
        const int c4 = C.tid % 24, rg = C.tid / 24;
        float* mod = (float*)(C.ws + WS_MOD);
        for (int s = blockIdx.x; s < 256; s += C.G) {
            if (rg < 21) {
                f32x4 acc = (f32x4){0.f, 0.f, 0.f, 0.f};
                const float* wp = INP(w_ada) + (size_t)rg * NMODV + 96 * s + 4 * c4;
#pragma unroll 8
                for (int r = rg; r < DM; r += 21) { const f32x4 w = __builtin_nontemporal_load((const f32x4*)wp); acc += cact[r] * w; wp += (size_t)21 * NMODV; }
                *(LAS f32x4*)(red + rg * 96 + 4 * c4) = acc;
            }
            __syncthreads();
            if (C.tid < 96) { float t = 0.f;
#pragma unroll
                for (int k = 0; k < 21; ++k) t += red[k * 96 + C.tid];
                mod[96 * s + C.tid] = t + INP(b_ada)[96 * s + C.tid]; }
            __syncthreads();
        }
    }
    {
        LAS float* scr = (LAS float*)(C.lds + RING_OFF + C.wave * 16384);
        const int gw = blockIdx.x * NWAVES + C.wave, NGW = C.G * NWAVES;
#if MK_FILL
        constexpr int I_IN = (DM / 64) * (INC / 32), I_PL = (512 / 64) * (512 / 32);
        constexpr int NITEMS = I_IN + 4 * I_PL;
        bf16* WIN = (bf16*)(C.ws + WS_WIN); bf16* WPL = (bf16*)(C.ws + WS_WPOOL);
        for (int it = gw; it < NITEMS; it += NGW) {
            int r = it;
            if (r < I_IN) { p0_transpose_item(INP(w_in), INC, WIN, DM, 0, 0, scr, r, C.lane); continue; } r -= I_IN;
            { const int g = r / I_PL; p0_transpose_item(INP(w_pool) + (size_t)g * 512 * 512, 512, WPL, 512, g * 512, 0, scr, r % I_PL, C.lane); }
        }
#else
        constexpr int I_IN = (DM / 64) * (INC / 32), I_F1 = (DM / 64) * (DFF / 32), I_F2 = (DFF / 64) * (DM / 32), I_PL = (512 / 64) * (512 / 32);
        constexpr int NITEMS = I_IN + I_F1 / 2 + I_F2 + 4 * I_PL;
        bf16* WIN = (bf16*)(C.ws + WS_WIN); bf16* WF1 = (bf16*)(C.ws + WS_WFF1); bf16* WF2 = (bf16*)(C.ws + WS_WFF2); bf16* WPL = (bf16*)(C.ws + WS_WPOOL);
        const float* p_in = INP(w_in); const float* p_f1 = INP(w_ff1); const float* p_f2 = INP(w_ff2); const float* p_pl = INP(w_pool);
        for (int it = gw; it < NITEMS; it += NGW) {
            int r = it;
            if (r < I_IN) { if ((r % (INC / 32)) * 32 >= 3 * DA) p0_transpose_item_f8(p_in, INC, (unsigned char*)(C.ws + WS_W8), DM, -3 * DA, W8_SCALE, scr, r, C.lane);
                            else p0_transpose_item(p_in, INC, WIN, DM, 0, 0, scr, r, C.lane); continue; } r -= I_IN;
            if (r < I_F1 / 2) { p0_transpose_item(p_f1, DFF, WF1, DM, 0, 0, scr, r + I_F1 / 2, C.lane); continue; } r -= I_F1 / 2;
            if (r < I_F2) { p0_transpose_item(p_f2, DM, WF2, DFF, 0, 0, scr, r, C.lane); continue; } r -= I_F2;
            { const int g = r / I_PL; p0_transpose_item(p_pl + (size_t)g * 512 * 512, 512, WPL, 512, g * 512, 0, scr, r % I_PL, C.lane); }
        }
#endif
        bf16* WSP = (bf16*)(C.ws + WS_WSP);
        for (int i = blockIdx.x * (NWAVES * 64) + C.tid; i < NH * CHK * CHK / 8; i += C.G * NWAVES * 64) {
            const int e0 = i * 8, t = (e0 >> 7) & 127, s0 = e0 & 127;
            const f32x4 a = *(const f32x4*)(INP(w_spatial) + e0), b = *(const f32x4*)(INP(w_spatial) + e0 + 4);
            float v[8] = {a.x, a.y, a.z, a.w, b.x, b.y, b.z, b.w};
#pragma unroll
            for (int e = 0; e < 8; ++e) v[e] = (s0 + e <= t) ? v[e] : 0.f;
            v4u o; o.x = pk2(v[0], v[1]); o.y = pk2(v[2], v[3]); o.z = pk2(v[4], v[5]); o.w = pk2(v[6], v[7]);
            *(v4u*)(WSP + e0) = o;
        }
    }
}
template <bool MODUL, bool XBF = false>
__device__ __forceinline__ void p_norm(Ctx& C, const void* Xv, const float* g, const float* shift, const float* scale, bf16* H, float* O, unsigned char* H8 = nullptr) {
    LAS float* ca = (LAS float*)(C.lds); LAS float* cb = (LAS float*)(C.lds + 16384);
    for (int i = C.tid; i < DM; i += NWAVES * 64) { if (MODUL) { ca[i] = g[i] * (1.0f + scale[i]); cb[i] = shift[i]; } else ca[i] = g[i]; }
    __syncthreads();
    const int gw = blockIdx.x * NWAVES + C.wave, NGW = C.G * NWAVES;
    for (int m = gw; m < SEQ; m += NGW) {
        f32x4 v[16]; float ss = 0.f;
        if constexpr (XBF) { const bf16* xr = (const bf16*)Xv + (size_t)m * DM + 8 * C.lane; v4u w[8];
#pragma unroll
            for (int j = 0; j < 8; ++j) w[j] = *(const v4u*)(xr + 512 * j);
#pragma unroll
            for (int j = 0; j < 8; ++j) { v[2 * j] = (f32x4){__uint_as_float(w[j].x << 16), __uint_as_float(w[j].x & 0xffff0000u), __uint_as_float(w[j].y << 16), __uint_as_float(w[j].y & 0xffff0000u)};
                v[2 * j + 1] = (f32x4){__uint_as_float(w[j].z << 16), __uint_as_float(w[j].z & 0xffff0000u), __uint_as_float(w[j].w << 16), __uint_as_float(w[j].w & 0xffff0000u)}; } }
        else { const float* xr = (const float*)Xv + (size_t)m * DM + 8 * C.lane;
#pragma unroll
            for (int j = 0; j < 8; ++j) { v[2 * j] = *(const f32x4*)(xr + 512 * j); v[2 * j + 1] = *(const f32x4*)(xr + 512 * j + 4); } }
#pragma unroll
        for (int j = 0; j < 16; ++j) ss += (v[j].x * v[j].x + v[j].y * v[j].y) + (v[j].z * v[j].z + v[j].w * v[j].w);
        const float rstd = 1.0f / sqrtf(wave_sum(ss) * (1.0f / DM) + EPS);
        int lo = 8 * C.lane; asm volatile("" : "+v"(lo));
#pragma unroll
        for (int j = 0; j < 8; ++j) {
            const f32x4 a0 = *(const LAS f32x4*)(ca + lo + 512 * j), a1 = *(const LAS f32x4*)(ca + lo + 512 * j + 4);
            if (MODUL) {
                const f32x4 b0 = *(const LAS f32x4*)(cb + lo + 512 * j), b1 = *(const LAS f32x4*)(cb + lo + 512 * j + 4);
                const f32x4 y0 = v[2 * j] * rstd * a0 + b0, y1 = v[2 * j + 1] * rstd * a1 + b1;
                v4u o; o.x = pk2(y0.x, y0.y); o.y = pk2(y0.z, y0.w); o.z = pk2(y1.x, y1.y); o.w = pk2(y1.z, y1.w);
                *(v4u*)(H + (size_t)m * DM + 8 * C.lane + 512 * j) = o;
                if (H8) { int d0 = __builtin_amdgcn_cvt_pk_fp8_f32(y0.x, y0.y, 0, false); d0 = __builtin_amdgcn_cvt_pk_fp8_f32(y0.z, y0.w, d0, true);
                          int d1 = __builtin_amdgcn_cvt_pk_fp8_f32(y1.x, y1.y, 0, false); d1 = __builtin_amdgcn_cvt_pk_fp8_f32(y1.z, y1.w, d1, true);
                          *(v2u*)(H8 + (size_t)m * DM + 8 * C.lane + 512 * j) = (v2u){(unsigned)d0, (unsigned)d1}; }
            } else {
                float* orow = O + (size_t)m * DM + 8 * C.lane + 512 * j;
                *(f32x4*)(orow) = v[2 * j] * rstd * a0; *(f32x4*)(orow + 4) = v[2 * j + 1] * rstd * a1;
            }
        }
    }
    __syncthreads();
}
__device__ __forceinline__ void p3_spatial(Ctx& C) {
    constexpr int LDW = 136;
    LAS bf16* WL = (LAS bf16*)(C.lds);
    LAS bf16* VL = (LAS bf16*)(C.lds + 34816);
    LAS float* MU = (LAS float*)(C.lds + 69632); LAS float* RS = MU + 128; LAS float* LG = RS + 128; LAS float* LB = LG + 128;
    const bf16* WSPb = (const bf16*)(C.ws + WS_WSP); const bf16* VT = (const bf16*)(C.ws + WS_VT); const bf16* U = (const bf16*)(C.ws + WS_U); bf16* ACAT = (bf16*)(C.ws + WS_ACAT);
    const f32x4* stats4 = (const f32x4*)(C.ws + WS_STATS);
    const int tid = C.tid, r0 = tid >> 4, c8 = tid & 15, fr = C.lane & 15, fq = C.lane >> 4, w = C.wave;
    const int NU = NCHUNK * NH;
    int hcur = -1;
    v4u vreg[4]; f32x4 sreg[2];
    int id = (int)blockIdx.x;
    if (id < NU) { const int n = id >> 4, h = id & 15;
#pragma unroll
        for (int j = 0; j < 4; ++j) vreg[j] = *(const v4u*)(VT + (size_t)(h * HD + r0 + 32 * j) * SEQ + n * CHK + c8 * 8);
        sreg[0] = stats4[(size_t)(n * CHK + (tid >> 2)) * 8 + (tid & 3) * 2]; sreg[1] = stats4[(size_t)(n * CHK + (tid >> 2)) * 8 + (tid & 3) * 2 + 1]; }
    for (; id < NU; id += C.G) {
        const int n = id >> 4, h = id & 15;
        if (h != hcur) {
            __syncthreads();
#pragma unroll
            for (int j = 0; j < 4; ++j) { const int r = r0 + 32 * j; *(LAS v4u*)(WL + r * LDW + c8 * 8) = *(const v4u*)(WSPb + (size_t)(h * CHK + r) * CHK + c8 * 8); }
            if (tid < 128) { LG[tid] = INP(ln_v_g)[h * HD + tid]; LB[tid] = INP(ln_v_b)[h * HD + tid]; }
            hcur = h;
        }
        {
            float s1 = (sreg[0].x + sreg[0].z) + (sreg[1].x + sreg[1].z), s2 = (sreg[0].y + sreg[0].w) + (sreg[1].y + sreg[1].w);
            s1 += __shfl_xor(s1, 1); s2 += __shfl_xor(s2, 1); s1 += __shfl_xor(s1, 2); s2 += __shfl_xor(s2, 2);
            const float mean = s1 * (1.0f / DA), var = fmaxf(s2 * (1.0f / DA) - mean * mean, 0.f);
            if ((tid & 3) == 0) { MU[tid >> 2] = mean; RS[tid >> 2] = 1.0f / sqrtf(var + EPS); }
        }
        __syncthreads();
#pragma unroll
        for (int j = 0; j < 4; ++j) { const int r = r0 + 32 * j; const float gg = LG[r], bb = LB[r];
            const f32x4 m0 = *(const LAS f32x4*)(MU + c8 * 8), m1 = *(const LAS f32x4*)(MU + c8 * 8 + 4), q0 = *(const LAS f32x4*)(RS + c8 * 8), q1 = *(const LAS f32x4*)(RS + c8 * 8 + 4);
            v4u o;
            o.x = pk2((bflo(vreg[j].x) - m0.x) * q0.x * gg + bb, (bfhi(vreg[j].x) - m0.y) * q0.y * gg + bb);
            o.y = pk2((bflo(vreg[j].y) - m0.z) * q0.z * gg + bb, (bfhi(vreg[j].y) - m0.w) * q0.w * gg + bb);
            o.z = pk2((bflo(vreg[j].z) - m1.x) * q1.x * gg + bb, (bfhi(vreg[j].z) - m1.y) * q1.y * gg + bb);
            o.w = pk2((bflo(vreg[j].w) - m1.z) * q1.z * gg + bb, (bfhi(vreg[j].w) - m1.w) * q1.w * gg + bb);
            *(LAS v4u*)(VL + r * LDW + c8 * 8) = o; }
        {
            const int idn = id + C.G;
            if (idn < NU) { const int nn = idn >> 4, hn = idn & 15;
#pragma unroll
                for (int j = 0; j < 4; ++j) vreg[j] = *(const v4u*)(VT + (size_t)(hn * HD + r0 + 32 * j) * SEQ + nn * CHK + c8 * 8);
                sreg[0] = stats4[(size_t)(nn * CHK + (tid >> 2)) * 8 + (tid & 3) * 2]; sreg[1] = stats4[(size_t)(nn * CHK + (tid >> 2)) * 8 + (tid & 3) * 2 + 1]; }
        }
        const int t = 16 * w + fr; const size_t tok = (size_t)n * CHK + t; const float bs = INP(b_spatial)[h * CHK + t];
        v2u uu[8];
#pragma unroll
        for (int it = 0; it < 8; ++it) uu[it] = *(const v2u*)(U + tok * DA + h * HD + 16 * it + 4 * fq);
        __syncthreads();
        f32x4 acc[8];
#pragma unroll
        for (int it = 0; it < 8; ++it) acc[it] = (f32x4){0.f, 0.f, 0.f, 0.f};
#pragma unroll
        for (int kk = 0; kk < 4; ++kk) {
            if (kk * 32 <= 16 * w + 15) {
                const bf16x8 bw = *(const LAS bf16x8*)(WL + (16 * w + fr) * LDW + kk * 32 + fq * 8);
#pragma unroll
                for (int it = 0; it < 8; ++it) { const bf16x8 av = *(const LAS bf16x8*)(VL + (16 * it + fr) * LDW + kk * 32 + fq * 8);
                    acc[it] = __builtin_amdgcn_mfma_f32_16x16x32_bf16(av, bw, acc[it], 0, 0, 0); }
            }
        }
#pragma unroll
        for (int it = 0; it < 8; ++it) { const int d0 = h * HD + 16 * it + 4 * fq;
            v2u o; o.x = pk2(bflo(uu[it].x) * (acc[it][0] + bs), bfhi(uu[it].x) * (acc[it][1] + bs)); o.y = pk2(bflo(uu[it].y) * (acc[it][2] + bs), bfhi(uu[it].y) * (acc[it][3] + bs));
            *(v2u*)(ACAT + tok * DM + d0) = o; }
    }
    __syncthreads();
}
template <int W>
__device__ __forceinline__ void p3_pool_item(const bf16* P, bf16* PO, int t0, int col) {
    v4u rows[W + 3];
#pragma unroll
    for (int j = 0; j < W + 3; ++j) { const int r = t0 - (W - 1) + j; rows[j] = *(const v4u*)(P + (size_t)(r < 0 ? 0 : r) * DB + col); }
#pragma unroll
    for (int i = 0; i < 4; ++i) { const int t = t0 + i; float sum[8];
#pragma unroll
        for (int e = 0; e < 8; ++e) sum[e] = 0.f;
#pragma unroll
        for (int j = 0; j < W; ++j) { const bool ok = (t - (W - 1) + j) >= 0; const v4u pv = rows[i + j];
#pragma unroll
            for (int q = 0; q < 4; ++q) { sum[2 * q] += ok ? bflo(pv[q]) : 0.f; sum[2 * q + 1] += ok ? bfhi(pv[q]) : 0.f; } }
        const int cnt = (t + 1 < W) ? (t + 1) : W; const float inv = 1.0f / (float)cnt; const v4u cv = rows[i + W - 1]; v4u o;
#pragma unroll
        for (int q = 0; q < 4; ++q) o[q] = pk2(sum[2 * q] * inv - bflo(cv[q]), sum[2 * q + 1] * inv - bfhi(cv[q]));
        *(v4u*)(PO + (size_t)t * DB + col) = o; }
}
__device__ __forceinline__ void p3_pooled(Ctx& C) {
    const bf16* P = (const bf16*)(C.ws + WS_P); bf16* PO = (bf16*)(C.ws + WS_POOLED);
    const int gw = blockIdx.x * NWAVES + C.wave, NGW = C.G * NWAVES;
    for (int wi = gw; wi < (SEQ / 4) * 4; wi += NGW) {
        const int g = wi & 3, t0 = (wi >> 2) * 4, col = g * 512 + C.lane * 8;
        if (g == 0) p3_pool_item<2>(P, PO, t0, col); else if (g == 1) p3_pool_item<4>(P, PO, t0, col); else if (g == 2) p3_pool_item<8>(P, PO, t0, col); else p3_pool_item<16>(P, PO, t0, col);
    }
}

#define WSP(T, off) ((T*)(C.ws + (off)))
#define MODV ((const float*)(C.ws + WS_MOD))
__device__ __forceinline__ void ph0(Ctx& C) { p0_prologue(C); }
__device__ __forceinline__ void ph1(Ctx& C) { p_norm<true>(C, INP(x), INP(norm1_g), MODV, MODV + DM, WSP(bf16, WS_H), nullptr, WSP(unsigned char, WS_H8)); }
__device__ __forceinline__ void ph2(Ctx& C) {
    const int bx = (int)blockIdx.x;
#if !defined(P2_ONLY) || P2_ONLY == 1
    { pg8::Gemm g{WSP(const bf16, WS_H), WSP(const bf16, WS_WIN), DM, DM, DM / 64}; pg8::SchedIn S{C.G, bx};
      pg8::EpiIn E{C.ws, (unsigned)(WS_U >> 20), (unsigned)(WS_P >> 20), (unsigned)(WS_GT >> 20), INP(b_gate)};
      pg8::gemm_phase<pg8::EpiIn, pg8::SchedIn, PG8_ALIGN, PG8_SP2>(C.lds + RING_OFF, g, S, E, pg8::NoFill(), nullptr, C.wave); }
#endif
#if !defined(P2_ONLY) || P2_ONLY == 3
    { pg8::Gemm g{WSP(const bf16, WS_H8), WSP(const bf16, WS_W8), DM / 2, DM / 2, DM / 128}; pg8::SchedPlain S{32, 32, C.G, bx, DM / 2, DM / 2};
      pg8::EpiGate E{WSP(bf16, WS_GT), INP(b_gate), 1.0f / W8_SCALE};
      pg8::FillConv<pg8::PickP2, 2> F{{INP(w_up_a), INP(w_up_b), INP(w_out), INP(w_ff1), (unsigned)(WS_WUP >> 20), (unsigned)(WS_WOUT >> 20), (unsigned)(WS_WFF1 >> 20)}, 0, C.G, bx, C.ws, C.lds + PTAB_OFF, (unsigned)WS_DUMP};
      pg8::gemm_phase<pg8::EpiGate, pg8::SchedPlain, PG8_ALIGN, PG8_SP2, pg8::FillConv<pg8::PickP2, 2>, true>(C.lds + RING_OFF, g, S, E, F, C.lds + SCR_OFF, C.wave); }
#endif
#if !defined(P2_ONLY) || P2_ONLY == 2
    { pg8::Gemm g{WSP(const bf16, WS_WIN) + (size_t)DA * DM, WSP(const bf16, WS_H), DM, DM, DM / 64}; pg8::SchedPlain S{8, 32, C.G, bx, DM, DM};
      pg8::EpiVT E{WSP(bf16, WS_VT), WSP(f32x2, WS_STATS)};
      pg8::gemm_phase<pg8::EpiVT, pg8::SchedPlain, PG8_ALIGN, PG8_SP2>(C.lds + RING_OFF, g, S, E, pg8::NoFill(), nullptr, C.wave); }
#endif
}
__device__ __forceinline__ void ph3(Ctx& C) {
    p3_pooled(C);
    p3_spatial(C);
}
__device__ __forceinline__ void ph4(Ctx& C) {
    pg8::Gemm g{WSP(const bf16, WS_POOLED), WSP(const bf16, WS_WPOOL), DB, 512, 512 / 64}; pg8::SchedPool S{C.G, (int)blockIdx.x};
    pg8::EpiPool E{WSP(bf16, WS_ACAT), INP(b_pool), INP(pool_scale)};
    pg8::gemm_phase<pg8::EpiPool, pg8::SchedPool, PG8_ALIGN, PG8_SP2>(C.lds + RING_OFF, g, S, E, pg8::NoFill(), nullptr, C.wave);
}
__device__ __forceinline__ void ph5(Ctx& C) {
    pg8::Gemm g{WSP(const bf16, WS_ACAT), WSP(const bf16, WS_WUP), DM, DM, DA / 64}; pg8::SchedUp S{C.G, (int)blockIdx.x};
    pg8::EpiUp E{WSP(const bf16, WS_GT), WSP(bf16, WS_MERGED)};
    pg8::FillConv<pg8::PickFF2> F{{INP(w_ff2), (unsigned)(WS_WFF2 >> 20)}, 0, C.G, (int)blockIdx.x, C.ws, C.lds + PTAB_OFF, (unsigned)WS_DUMP};
#if MK_FILL
    pg8::gemm_phase<pg8::EpiUp, pg8::SchedUp, PG8_ALIGN, PG8_SP2, pg8::FillConv<pg8::PickFF2>>(C.lds + RING_OFF, g, S, E, F, C.lds + SCR_OFF, C.wave);
#else
    (void)F; pg8::gemm_phase<pg8::EpiUp, pg8::SchedUp, PG8_ALIGN, PG8_SP2>(C.lds + RING_OFF, g, S, E, pg8::NoFill(), nullptr, C.wave);
#endif
}
__device__ __forceinline__ void ph6(Ctx& C) {
    pg8::Gemm g{WSP(const bf16, WS_MERGED), WSP(const bf16, WS_WOUT), DM, DM, DM / 64}; pg8::SchedPlain S{32, 16, C.G, (int)blockIdx.x, DM, DM};
    pg8::EpiRes<false, X1_BF16> E{INP(x), MODV + 2 * DM, WSP(void, WS_X1)};
    pg8::FillConv<pg8::PickFF2> F{{INP(w_ff2), (unsigned)(WS_WFF2 >> 20)}, 16384, C.G, (int)blockIdx.x, C.ws, C.lds + PTAB_OFF, (unsigned)WS_DUMP};
#if MK_FILL
    pg8::gemm_phase<pg8::EpiRes<false, X1_BF16>, pg8::SchedPlain, PG8_ALIGN, PG8_SP2, pg8::FillConv<pg8::PickFF2>>(C.lds + RING_OFF, g, S, E, F, C.lds + SCR_OFF, C.wave);
#else
    (void)F; pg8::gemm_phase<pg8::EpiRes<false, X1_BF16>, pg8::SchedPlain, PG8_ALIGN, PG8_SP2>(C.lds + RING_OFF, g, S, E, pg8::NoFill(), nullptr, C.wave);
#endif
}
__device__ __forceinline__ void ph7(Ctx& C) { p_norm<true, X1_BF16>(C, WSP(const void, WS_X1), INP(norm2_g), MODV + 3 * DM, MODV + 4 * DM, WSP(bf16, WS_H), nullptr); }
__device__ __forceinline__ void ph8(Ctx& C) {
    pg8::Gemm g{WSP(const bf16, WS_H), WSP(const bf16, WS_WFF1), DM, DM, DM / 64}; pg8::SchedPlain S{32, 64, C.G, (int)blockIdx.x, DM, DM};
    pg8::EpiFF1 E{WSP(bf16, WS_HID)};
    pg8::gemm_phase<pg8::EpiFF1, pg8::SchedPlain, PG8_ALIGN, PG8_SP2>(C.lds + RING_OFF, g, S, E, pg8::NoFill(), nullptr, C.wave);
}
__device__ __forceinline__ void ph9(Ctx& C) {
    pg8::Gemm g{WSP(const bf16, WS_HID), WSP(const bf16, WS_WFF2), DFF, DFF, DFF / 64}; pg8::SchedPlain S{32, 16, C.G, (int)blockIdx.x, DFF, DFF};
    pg8::EpiRes<X1_BF16, X2_BF16> E{WSP(const void, WS_X1), MODV + 5 * DM, X2_BF16 ? WSP(void, WS_H) : (void*)OUTP};
    pg8::gemm_phase<pg8::EpiRes<X1_BF16, X2_BF16>, pg8::SchedPlain, PG8_ALIGN, PG8_SP2>(C.lds + RING_OFF, g, S, E, pg8::NoFill(), nullptr, C.wave);
}
__device__ __forceinline__ void ph10(Ctx& C) { p_norm<false, X2_BF16>(C, X2_BF16 ? WSP(const void, WS_H) : (const void*)OUTP, INP(norm_f_g), nullptr, nullptr, nullptr, OUTP); }

#ifndef PH_MASK
#define PH_MASK 0x7ff
#endif
#ifndef REPEAT_MASK
#define REPEAT_MASK 0
#endif
struct Args { const float* in[21]; float* out; unsigned char* ws; int ph_lo, ph_hi; };
__global__ void __launch_bounds__(NWAVES * 64, 2) mk_fwd(Args args) {
    extern __shared__ __attribute__((aligned(16))) unsigned char lds[];
    Ctx C;
    C.lds = (LAS unsigned char*)lds;
    C.tid = threadIdx.x; C.lane = C.tid & 63; C.wave = __builtin_amdgcn_readfirstlane(C.tid >> 6); C.G = gridDim.x;
    C.ws = args.ws;
    unsigned char* ws = args.ws;
    volatile LAS unsigned* MISC = (volatile LAS unsigned*)(C.lds + MISC_OFF);
    for (int u = C.tid; u < (LDS_BYTES - LDSCTL_OFF) / 4; u += NWAVES * 64) ((LAS unsigned*)(C.lds + LDSCTL_OFF))[u] = 0u;
    if (C.tid < IN_COUNT) { unsigned long long p = (unsigned long long)args.out;
#pragma unroll
        for (int k = 0; k < 21; ++k) if (C.tid == k) p = (unsigned long long)args.in[k];
        LAS unsigned* tb = (LAS unsigned*)(C.lds + PTAB_OFF) + 2 * C.tid; tb[0] = (unsigned)p; tb[1] = (unsigned)(p >> 32); }
    __syncthreads();
    XcdBarrier bar; bar.bar = (unsigned*)(ws + WS_CTL) + CW_BAR; bar.x = 0; bar.st = nullptr;
    if (!MK_PER_PHASE) bar = xcd_barrier_post((unsigned*)(ws + WS_CTL) + CW_BAR, MISC + 8);
    const int lo = args.ph_lo, hi = args.ph_hi;
#define IN(k) (((PH_MASK >> (k)) & 1) && lo <= (k) && (k) < hi)
#define SEAM(k) do { if (IN(k) && IN((k) + 1)) xcd_barrier(bar); } while (0)
#define PHASE(k, fn) do { if (IN(k)) { C.lane = (int)__builtin_amdgcn_mbcnt_hi(~0u, __builtin_amdgcn_mbcnt_lo(~0u, 0u)); C.tid = C.wave * 64 + C.lane; asm volatile("" : "+v"(C.tid)); C.lane = C.tid & 63; fn(C); if ((REPEAT_MASK >> (k)) & 1) { __syncthreads(); fn(C); } } } while (0)
    PHASE(0, ph0); SEAM(0);
    PHASE(1, ph1); SEAM(1);
    PHASE(2, ph2); SEAM(2);
    PHASE(3, ph3); SEAM(3);
    PHASE(4, ph4); SEAM(4);
    PHASE(5, ph5); SEAM(5);
    PHASE(6, ph6); SEAM(6);
    PHASE(7, ph7); SEAM(7);
    PHASE(8, ph8); SEAM(8);
    PHASE(9, ph9); SEAM(9);
    PHASE(10, ph10);
#undef IN
#undef SEAM
#undef PHASE
}

extern "C" void kernel_launch(void* const* d_in, const int* in_sizes, int n_in, void* d_out, int out_size, void* d_ws, size_t ws_size, hipStream_t stream) {
    static int grid = 0;
    if (grid == 0) {
        if (n_in != 21 || in_sizes[0] != SEQ * DM || out_size != SEQ * DM || ws_size < WS_END) { fprintf(stderr, "kernel_launch: unexpected shapes (n_in %d, in0 %d, out %d, ws %zu < %zu); nothing launched\n", n_in, n_in > 0 ? in_sizes[0] : -1, out_size, ws_size, (size_t)WS_END); grid = -1; return; }
        int dev = 0, cus = 0, per_cu = 0;
        if (hipGetDevice(&dev) != hipSuccess || hipDeviceGetAttribute(&cus, hipDeviceAttributeMultiprocessorCount, dev) != hipSuccess) { fprintf(stderr, "kernel_launch: device query failed\n"); grid = -1; return; }
        if (hipFuncSetAttribute((const void*)mk_fwd, hipFuncAttributeMaxDynamicSharedMemorySize, LDS_BYTES) != hipSuccess) { fprintf(stderr, "kernel_launch: hipFuncSetAttribute failed\n"); grid = -1; return; }
        if (hipOccupancyMaxActiveBlocksPerMultiprocessor(&per_cu, (const void*)mk_fwd, NWAVES * 64, LDS_BYTES) != hipSuccess || per_cu < 1) { fprintf(stderr, "kernel_launch: occupancy query says %d workgroups per CU\n", per_cu); }
        (void)hipGetLastError();
        if (cus != 256) fprintf(stderr, "kernel_launch: built for 256 CUs (whole rounds per phase, in-loop weight conversion deal); this device has %d\n", cus);
        grid = 256;
    }
    if (grid < 0) return;
    if (hipMemsetAsync((char*)d_ws + WS_CTL, 0, CTL_ZERO_BYTES, stream) != hipSuccess) { fprintf(stderr, "kernel_launch: memset failed\n"); return; }
    Args a{};
    for (int i = 0; i < 21; ++i) a.in[i] = (const float*)d_in[i];
    a.out = (float*)d_out; a.ws = (unsigned char*)d_ws;
#if MK_PER_PHASE
    for (int p = 0; p < N_PHASES; ++p) { a.ph_lo = p; a.ph_hi = p + 1; hipLaunchKernelGGL(mk_fwd, dim3(grid), dim3(NWAVES * 64), LDS_BYTES, stream, a); }
#else
    a.ph_lo = 0; a.ph_hi = N_PHASES; hipLaunchKernelGGL(mk_fwd, dim3(grid), dim3(NWAVES * 64), LDS_BYTES, stream, a);
#endif
    const hipError_t le = hipPeekAtLastError();
    if (le != hipSuccess) fprintf(stderr, "kernel_launch: launch failed: %s\n", hipGetErrorName(le));
}
```
